# Optimizing an MI355X kernel written in HIP

```python
import jax, jax.numpy as jnp
from jax import lax
import numpy as np

D_MODEL = 1024
BATCH = 2
SEQ = 8192
DEPTH = 4

MEM_LEN = 256
HEAD_DIM = 64
N_CONV_GROUPS = 6
CONV_CH = N_CONV_GROUPS * HEAD_DIM
CONV_WIDTH = 31
N_Q_HEADS = 6
N_KV_HEADS = 2
SWA_Q = N_Q_HEADS * HEAD_DIM
SWA_KV = N_KV_HEADS * HEAD_DIM
WINDOW = 128
BLOCK = 128
N_MEM_HEADS = 4
MEM_W = N_MEM_HEADS * HEAD_DIM
D_MIX = CONV_CH + SWA_Q + MEM_W
D_IN = 2 * CONV_CH + SWA_Q + 2 * SWA_KV + MEM_W
D_FF = 2816
ROPE_THETA = 10000.0
EPS = 1e-6

kernel_name = "hymba_style_conformer_swa_memory_macaron"


def rms_norm(x, g):
    xf = x.astype(jnp.float32)
    y = xf * lax.rsqrt(jnp.mean(xf * xf, axis=-1, keepdims=True) + EPS)
    return (y * g.astype(jnp.float32)).astype(x.dtype)


def layer_norm(x, g, b):
    xf = x.astype(jnp.float32)
    mu = jnp.mean(xf, axis=-1, keepdims=True)
    var = jnp.mean(jnp.square(xf - mu), axis=-1, keepdims=True)
    y = (xf - mu) * lax.rsqrt(var + EPS)
    return (y * g.astype(jnp.float32) + b.astype(jnp.float32)).astype(x.dtype)


def swiglu(x, w1, w3, w2):
    return (jax.nn.silu(x @ w1) * (x @ w3)) @ w2


def rope_tables(positions):
    inv_freq = ROPE_THETA ** (-jnp.arange(0, HEAD_DIM, 2, dtype=jnp.float32) / HEAD_DIM)
    ang = positions.astype(jnp.float32)[..., None] * inv_freq
    return jnp.cos(ang)[:, :, None, :], jnp.sin(ang)[:, :, None, :]


def apply_rope(x, cos, sin):
    xf = x.astype(jnp.float32)
    x1, x2 = jnp.split(xf, 2, axis=-1)
    out = jnp.concatenate([x1 * cos - x2 * sin, x2 * cos + x1 * sin], axis=-1)
    return out.astype(x.dtype)


def conv_module(u, w_dw, b_dw, ln_g, ln_b):
    a, gate = jnp.split(u, 2, axis=-1)
    y = a * jax.nn.sigmoid(gate)
    y = lax.conv_general_dilated(
        y, w_dw[:, None, :], window_strides=(1,),
        padding=[(CONV_WIDTH - 1, 0)],
        dimension_numbers=('NWC', 'WIO', 'NWC'),
        feature_group_count=CONV_CH) + b_dw
    y = layer_norm(y, ln_g, ln_b)
    return jax.nn.silu(y)


def sliding_window_attention(q, k, v, sinks):
    B, S, _, Dh = q.shape
    nb = S // BLOCK
    g = N_Q_HEADS // N_KV_HEADS
    qb = q.reshape(B, nb, BLOCK, N_KV_HEADS, g, Dh)
    kb = k.reshape(B, nb, BLOCK, N_KV_HEADS, Dh)
    vb = v.reshape(B, nb, BLOCK, N_KV_HEADS, Dh)

    def with_prev(t):
        prev = jnp.concatenate([jnp.zeros_like(t[:, :1]), t[:, :-1]], axis=1)
        return jnp.concatenate([prev, t], axis=2)

    kw, vw = with_prev(kb), with_prev(vb)
    scores = jnp.einsum('bnqhgd,bnkhd->bnhgqk', qb, kw).astype(jnp.float32) * (Dh ** -0.5)
    qi = jnp.arange(BLOCK)[:, None] + BLOCK
    kj = jnp.arange(2 * BLOCK)[None, :]
    rel = qi - kj
    band = (rel >= 0) & (rel < WINDOW)
    first_ok = (jnp.arange(nb)[:, None, None] > 0) | (kj[None] >= BLOCK)
    mask = band[None] & first_ok
    scores = jnp.where(mask[None, :, None, None], scores, -jnp.inf)
    sink = jnp.broadcast_to(
        sinks.astype(jnp.float32).reshape(N_KV_HEADS, g)[None, None, :, :, None, None],
        scores.shape[:-1] + (1,))
    probs = jax.nn.softmax(jnp.concatenate([scores, sink], axis=-1), axis=-1)[..., :-1]
    out = jnp.einsum('bnhgqk,bnkhd->bnqhgd', probs.astype(v.dtype), vw)
    return out.reshape(B, S, N_Q_HEADS * Dh)


def memory_attention(q, mk, mv):
    B, S, _, Dh = q.shape
    scores = jnp.einsum('bshd,bmhd->bhsm', q, mk).astype(jnp.float32) * (Dh ** -0.5)
    probs = jax.nn.softmax(scores, axis=-1)
    out = jnp.einsum('bhsm,bmhd->bshd', probs.astype(mv.dtype), mv)
    return out.reshape(B, S, N_MEM_HEADS * Dh)


def setup_inputs(seed: int = 0) -> dict:
    key = jax.random.key(seed)
    ks = iter(jax.random.split(key, 32))
    f32 = jnp.float32

    def w(shape, fan_in):
        return jax.random.normal(next(ks), shape, f32) * (fan_in ** -0.5)

    def gain(shape):
        return 1.0 + 0.02 * jax.random.normal(next(ks), shape, f32)

    def bias(shape):
        return 0.02 * jax.random.normal(next(ks), shape, f32)

    L = DEPTH
    x = jax.random.normal(next(ks), (BATCH, SEQ, D_MODEL), f32)
    mem = jax.random.normal(next(ks), (BATCH, MEM_LEN, D_MODEL), f32)
    positions = jnp.broadcast_to(jnp.arange(SEQ, dtype=jnp.int32)[None, :], (BATCH, SEQ))
    return {
        "x": x,
        "mem": mem,
        "positions": positions,
        "ffn1_norm": gain((L, D_MODEL)),
        "ffn1_w1": w((L, D_MODEL, D_FF), D_MODEL),
        "ffn1_w3": w((L, D_MODEL, D_FF), D_MODEL),
        "ffn1_w2": w((L, D_FF, D_MODEL), D_FF),
        "mix_norm": gain((L, D_MODEL)),
        "w_in": w((L, D_MODEL, D_IN), D_MODEL),
        "conv_w": w((L, CONV_WIDTH, CONV_CH), CONV_WIDTH),
        "conv_b": bias((L, CONV_CH)),
        "conv_ln_g": gain((L, CONV_CH)),
        "conv_ln_b": bias((L, CONV_CH)),
        "swa_q_norm": gain((L, HEAD_DIM)),
        "swa_k_norm": gain((L, HEAD_DIM)),
        "swa_sinks": jax.random.normal(next(ks), (L, N_Q_HEADS), f32),
        "mem_norm": gain((L, D_MODEL)),
        "w_mem_kv": w((L, D_MODEL, 2 * MEM_W), D_MODEL),
        "mem_q_norm": gain((L, HEAD_DIM)),
        "mem_k_norm": gain((L, HEAD_DIM)),
        "w_out": w((L, D_MIX, D_MODEL), D_MIX),
        "ffn2_norm": gain((L, D_MODEL)),
        "ffn2_w1": w((L, D_MODEL, D_FF), D_MODEL),
        "ffn2_w3": w((L, D_MODEL, D_FF), D_MODEL),
        "ffn2_w2": w((L, D_FF, D_MODEL), D_FF),
        "final_norm": gain((L, D_MODEL)),
    }


def reference(x, mem, positions, ffn1_norm, ffn1_w1, ffn1_w3, ffn1_w2, mix_norm, w_in,
              conv_w, conv_b, conv_ln_g, conv_ln_b, swa_q_norm, swa_k_norm, swa_sinks,
              mem_norm, w_mem_kv, mem_q_norm, mem_k_norm, w_out,
              ffn2_norm, ffn2_w1, ffn2_w3, ffn2_w2, final_norm):
    B, S, _ = x.shape
    cos, sin = rope_tables(positions)
    splits = [2 * CONV_CH, 2 * CONV_CH + SWA_Q, 2 * CONV_CH + SWA_Q + SWA_KV,
              2 * CONV_CH + SWA_Q + 2 * SWA_KV]
    for l in range(DEPTH):
        h = x + 0.5 * swiglu(rms_norm(x, ffn1_norm[l]), ffn1_w1[l], ffn1_w3[l], ffn1_w2[l])

        n = rms_norm(h, mix_norm[l])
        p = n @ w_in[l]
        u_conv, q, k, v, q_mem = jnp.split(p, splits, axis=-1)

        y_conv = conv_module(u_conv, conv_w[l], conv_b[l], conv_ln_g[l], conv_ln_b[l])

        q = apply_rope(rms_norm(q.reshape(B, S, N_Q_HEADS, HEAD_DIM), swa_q_norm[l]), cos, sin)
        k = apply_rope(rms_norm(k.reshape(B, S, N_KV_HEADS, HEAD_DIM), swa_k_norm[l]), cos, sin)
        v = v.reshape(B, S, N_KV_HEADS, HEAD_DIM)
        y_swa = sliding_window_attention(q, k, v, swa_sinks[l])

        mkv = rms_norm(mem, mem_norm[l]) @ w_mem_kv[l]
        mk, mv = jnp.split(mkv, 2, axis=-1)
        mk = rms_norm(mk.reshape(B, MEM_LEN, N_MEM_HEADS, HEAD_DIM), mem_k_norm[l])
        mv = mv.reshape(B, MEM_LEN, N_MEM_HEADS, HEAD_DIM)
        qm = rms_norm(q_mem.reshape(B, S, N_MEM_HEADS, HEAD_DIM), mem_q_norm[l])
        y_mem = memory_attention(qm, mk, mv)

        y = jnp.concatenate([y_conv, y_swa, y_mem], axis=-1)
        h = h + y @ w_out[l]

        h = h + 0.5 * swiglu(rms_norm(h, ffn2_norm[l]), ffn2_w1[l], ffn2_w3[l], ffn2_w2[l])

        x = rms_norm(h, final_norm[l])
    return x
```

```cpp
#include <hip/hip_runtime.h>
#include <hip/hip_cooperative_groups.h>
#include <cstdio>
#include <cstdint>
namespace cg = cooperative_groups;

#define LAS __attribute__((address_space(3)))
typedef unsigned short bf16_t;
typedef short bf16x8 __attribute__((ext_vector_type(8)));
typedef short s16x4 __attribute__((ext_vector_type(4)));
typedef float f32x4 __attribute__((ext_vector_type(4)));
typedef unsigned u32x4 __attribute__((ext_vector_type(4)));
typedef unsigned u32x2 __attribute__((ext_vector_type(2)));
typedef float f32x2 __attribute__((ext_vector_type(2)));

constexpr int DM = 1024, BATCH = 2, SEQ = 8192, DEPTH = 4, MEMLEN = 256, HD = 64;
constexpr int M = BATCH * SEQ;
constexpr int CONVC = 384, CONVW = 31;
constexpr int DIN = 1664, DINP = 1792;
constexpr int DFF = 2816;
constexpr int MROWS = BATCH * MEMLEN;
constexpr float EPS = 1e-6f;
constexpr int PC_A = 0, PC_G = 384, PC_Q = 768, PC_K = 1152, PC_V = 1280, PC_QM = 1408;
constexpr int YC_CONV = 0, YC_SWA = 384, YC_MEM = 768;

constexpr size_t MiB = 1u << 20;
constexpr size_t WS_PA = 0 * MiB, WS_PB = 1 * MiB, WS_PC = 2 * MiB;
constexpr size_t WS_XBUF = 3 * MiB + 256 * 1024;
constexpr int CW_PANEL = 8192;
constexpr size_t WS_PM = 3 * MiB;
constexpr size_t WS_COS = 4 * MiB, WS_SIN = 6 * MiB;
constexpr size_t WS_MEMB = 8 * MiB;
constexpr size_t WS_MKV = 9 * MiB;
constexpr size_t WS_CTL = 12 * MiB, CTL_ZERO_BYTES = 65536;
constexpr size_t WS_W = 16 * MiB;
constexpr size_t SZ_W13 = (size_t)2 * DFF * DM * 2, SZ_W2 = (size_t)DM * DFF * 2, SZ_WIN = (size_t)DINP * DM * 2, SZ_WOUT = (size_t)DM * DM * 2;
constexpr size_t OFF_W13A = 0, OFF_W2A = OFF_W13A + SZ_W13, OFF_WIN = OFF_W2A + SZ_W2, OFF_WOUT = OFF_WIN + SZ_WIN, OFF_W13B = OFF_WOUT + SZ_WOUT, OFF_W2B = OFF_W13B + SZ_W13;
constexpr size_t SZ_LAYER = OFF_W2B + SZ_W2;
constexpr size_t WS_WM = WS_W + 4 * SZ_LAYER;
constexpr size_t WS_RB = 176 * MiB;
constexpr size_t WS_FF = 208 * MiB;
constexpr size_t WS_P = WS_FF, WS_Y = WS_FF + 56 * MiB;
constexpr size_t WS_END = 296 * MiB;
static_assert(WS_WM + (size_t)2048 * 1024 * 2 <= WS_RB, "ws map");
static_assert(SZ_LAYER == (size_t)77 * MiB / 2, "layer weights 38.5 MiB");

constexpr int LDS_BYTES = 147456;
constexpr int LDS_RS_OFF = 131072 + 64;
constexpr int LDS_MISC = 131072;

__device__ __forceinline__ unsigned cvt_pk_bf16(float lo, float hi) { unsigned r; asm volatile("v_cvt_pk_bf16_f32 %0, %1, %2" : "=v"(r) : "v"(lo), "v"(hi)); return r; }
__device__ __forceinline__ float bf2f(short s) { return __uint_as_float(((unsigned)(unsigned short)s) << 16); }
__device__ __forceinline__ float wave_sum(float v) {
#pragma unroll
    for (int o = 1; o < 64; o <<= 1) v += __shfl_xor(v, o);
    return v;
}
__device__ __forceinline__ float fast_rcp(float x) { return __builtin_amdgcn_rcpf(x); }
__device__ __forceinline__ float silu_f(float x) { return x * fast_rcp(1.0f + __builtin_amdgcn_exp2f(-1.4426950408889634f * x)); }
__device__ __forceinline__ float sigmoid_f(float x) { return fast_rcp(1.0f + __builtin_amdgcn_exp2f(-1.4426950408889634f * x)); }

__device__ __forceinline__ void store16_wt(void* p, u32x4 v) { asm volatile("global_store_dwordx4 %0, %1, off sc1\n\ts_nop 1" :: "v"(p), "v"(v) : "memory"); }
__device__ __forceinline__ void store8_wt(void* p, u32x2 v) { asm volatile("global_store_dwordx2 %0, %1, off sc1\n\ts_nop 1" :: "v"(p), "v"(v) : "memory"); }
__device__ __forceinline__ int opaque_tid() { int t = threadIdx.x; asm volatile("" : "+v"(t)); return t; }
__device__ __forceinline__ unsigned opaque_zero() { unsigned z = 0u; asm volatile("" : "+v"(z)); return z; }
__device__ __forceinline__ int opaque_bid() { int t = blockIdx.x; asm volatile("" : "+s"(t)); return t; }
template <class T> __device__ __forceinline__ T* opaque_ptr(T* q) { asm volatile("" : "+s"(q)); return q; }

__device__ __forceinline__ unsigned xb_ld(unsigned* p);
__device__ __forceinline__ unsigned xb_add(unsigned* p, unsigned v);
#ifndef PG8_SP2_DEFAULT
#define PG8_SP2_DEFAULT true
#endif
namespace pg8 {
constexpr int BM = 256, BK = 64, HALF = 128, HTB = HALF * BK * 2, STAGE_BYTES = 8 * HTB, NXCD = 8, WGM = 8;
__host__ __device__ __forceinline__ int lds_byte(int r, int c) { const int st = (r >> 4) * 2 + (c >> 5), rr = r & 15, cc = c & 31, ob = rr * 64 + cc * 2; return st * 1024 + (ob ^ (((ob >> 9) & 1) << 5)); }
__host__ __device__ __forceinline__ void stage_rc(int b, int& R, int& C) { const int st = b / 1024, sb = b % 1024, swz = sb ^ (((sb >> 9) & 1) << 5); R = (st >> 1) * 16 + swz / 64; C = (st & 1) * 32 + (swz % 64) / 2; }
__host__ __device__ __forceinline__ int perm32(int rho) { const int n = rho >> 4, i = rho & 15; return 8 * (i >> 2) + 4 * n + (i & 3); }

struct Unit { int pm, pn; };
struct Gemm { const bf16_t* A; const bf16_t* Bt; int M, N, K; };

struct StaticOrder {
    int nM, nN, nwg, G, c;
    __device__ void init(int M_, int N_, int G_, int c_) { nM = M_ / BM; nN = N_ / BM; nwg = nM * nN; G = G_; c = c_; }
    __device__ bool next(int i, Unit& u) const {
        const long L = (long)i * G + c; if (L >= nwg) return false;
        int wgid = (int)L; { const int q = nwg / NXCD, r = nwg % NXCD, xcd = wgid % NXCD, off = wgid / NXCD; wgid = (xcd < r ? xcd * (q + 1) : r * (q + 1) + (xcd - r) * q) + off; }
        const int nig = WGM * nN, gid = wgid / nig, fm = gid * WGM, gsz = (nM - fm) < WGM ? (nM - fm) : WGM;
        u.pm = fm + ((wgid % nig) % gsz); u.pn = (wgid % nig) / gsz; return true;
    }
};

struct PanelOrder {
    int nN, pm, k;
    __device__ void init(int N_, int c_) { nN = N_ / BM; const int j = c_ >> 3; pm = 8 * (c_ & 7) + (j & 7); k = j >> 3; }
    __device__ bool next(int i, Unit& u) const { const int pn = k + 4 * i; if (pn >= nN) return false; u.pm = pm; u.pn = pn; return true; }
};


struct RowScaleSpec { const float* PA; const float* PB; int useA, withB; };
__device__ __forceinline__ void read_row_scales(LAS const float* rst, int wr, int fr, float (&rs)[2][4]) {
#pragma unroll
    for (int ai = 0; ai < 2; ++ai)
#pragma unroll
        for (int m = 0; m < 4; ++m) rs[ai][m] = rst[ai * HALF + wr * 64 + m * 16 + fr];
}

struct EpiSwiglu {
    static constexpr bool PERM = true;
    bf16_t* O; RowScaleSpec rsp;
    __device__ __forceinline__ void operator()(const f32x4 (&acc)[2][2][4][2], const Unit& u, int wr, int wc, int fr, int fq, LAS const float* rst) const {
        asm volatile("" : "+v"(fr), "+v"(fq));
        const int row0 = u.pm * BM + wr * 64 + fr, col0 = u.pn * HALF + wc * 32 + 8 * fq;
        float rs[2][4];
        read_row_scales(rst, wr, fr, rs);
#pragma unroll
        for (int ai = 0; ai < 2; ++ai)
#pragma unroll
            for (int m = 0; m < 4; ++m) {
                const float r = rs[ai][m], nr = -1.4426950408889634f * r, r2 = r * r;
                float o[8];
#pragma unroll
                for (int n = 0; n < 2; ++n)
#pragma unroll
                    for (int jp = 0; jp < 2; ++jp) {
                        const f32x2 a = {acc[ai][0][m][n][2 * jp], acc[ai][0][m][n][2 * jp + 1]}, b = {acc[ai][1][m][n][2 * jp], acc[ai][1][m][n][2 * jp + 1]};
                        const f32x2 t = a * nr; f32x2 e; e.x = __builtin_amdgcn_exp2f(t.x); e.y = __builtin_amdgcn_exp2f(t.y);
                        const f32x2 d = e + 1.0f; f32x2 q; q.x = __builtin_amdgcn_rcpf(d.x); q.y = __builtin_amdgcn_rcpf(d.y);
                        const f32x2 ov = (a * b) * (q * r2);
                        o[4 * n + 2 * jp] = ov.x; o[4 * n + 2 * jp + 1] = ov.y;
                    }
                u32x4 w; w.x = cvt_pk_bf16(o[0], o[1]); w.y = cvt_pk_bf16(o[2], o[3]); w.z = cvt_pk_bf16(o[4], o[5]); w.w = cvt_pk_bf16(o[6], o[7]);
                store16_wt(O + (size_t)(row0 + ai * HALF + m * 16) * DFF + col0, w);
            }
    }
};
struct EpiProj {
    static constexpr bool PERM = true;
    bf16_t* O; int ldc; RowScaleSpec rsp;
    __device__ __forceinline__ void operator()(const f32x4 (&acc)[2][2][4][2], const Unit& u, int wr, int wc, int fr, int fq, LAS const float* rst) const {
        asm volatile("" : "+v"(fr), "+v"(fq));
        const int row0 = u.pm * BM + wr * 64 + fr, col0 = u.pn * BM + wc * 32 + 8 * fq;
        float rs[2][4];
        read_row_scales(rst, wr, fr, rs);
#pragma unroll
        for (int ai = 0; ai < 2; ++ai)
#pragma unroll
            for (int m = 0; m < 4; ++m) {
                const float r = rs[ai][m];
#pragma unroll
                for (int bj = 0; bj < 2; ++bj) {
                    const f32x4 v0 = acc[ai][bj][m][0] * r, v1 = acc[ai][bj][m][1] * r;
                    u32x4 w; w.x = cvt_pk_bf16(v0[0], v0[1]); w.y = cvt_pk_bf16(v0[2], v0[3]); w.z = cvt_pk_bf16(v1[0], v1[1]); w.w = cvt_pk_bf16(v1[2], v1[3]);
                    store16_wt(O + (size_t)(row0 + ai * HALF + m * 16) * ldc + col0 + bj * HALF, w);
                }
            }
    }
};
struct EpiResid {
    static constexpr bool PERM = true;
    bf16_t* ob; RowScaleSpec rsp; float alpha; const float* gf; float* P1; float* P2;
    __device__ __forceinline__ void operator()(const f32x4 (&acc)[2][2][4][2], const Unit& u, int wr, int wc, int fr, int fq, LAS const float* rst) const {
        asm volatile("" : "+v"(fr), "+v"(fq));
        const int row0 = u.pm * BM + wr * 64 + fr, col0 = u.pn * BM + wc * 32 + 8 * fq;
        float r3[2][4];
        read_row_scales(rst, wr, fr, r3);
        f32x4 g[2][2];
#pragma unroll
        for (int bj = 0; bj < 2; ++bj)
#pragma unroll
            for (int n = 0; n < 2; ++n) g[bj][n] = gf ? *(const f32x4*)(gf + col0 + bj * HALF + 4 * n) : (f32x4){1.f, 1.f, 1.f, 1.f};
#pragma unroll
        for (int ai = 0; ai < 2; ++ai) {
            bf16x8 rb[4][2];
#pragma unroll
            for (int m = 0; m < 4; ++m)
#pragma unroll
                for (int bj = 0; bj < 2; ++bj) rb[m][bj] = *(const bf16x8*)(ob + (size_t)(row0 + ai * HALF + m * 16) * DM + col0 + bj * HALF);
#pragma unroll
            for (int m = 0; m < 4; ++m) {
                const int row = row0 + ai * HALF + m * 16; const size_t off = (size_t)row * DM + col0;
                float s1 = 0.f, s2 = 0.f;
#pragma unroll
                for (int bj = 0; bj < 2; ++bj) {
                    const bf16x8 t = rb[m][bj];
                    const f32x4 i0 = (f32x4){bf2f(t[0]), bf2f(t[1]), bf2f(t[2]), bf2f(t[3])}, i1 = (f32x4){bf2f(t[4]), bf2f(t[5]), bf2f(t[6]), bf2f(t[7])};
                    const f32x4 h0 = i0 * r3[ai][m] + acc[ai][bj][m][0] * alpha, h1 = i1 * r3[ai][m] + acc[ai][bj][m][1] * alpha;
                    s1 += (h0[0] * h0[0] + h0[1] * h0[1]) + (h0[2] * h0[2] + h0[3] * h0[3]) + (h1[0] * h1[0] + h1[1] * h1[1]) + (h1[2] * h1[2] + h1[3] * h1[3]);
                    const f32x4 z0 = h0 * g[bj][0], z1 = h1 * g[bj][1];
                    s2 += (z0[0] * z0[0] + z0[1] * z0[1]) + (z0[2] * z0[2] + z0[3] * z0[3]) + (z1[0] * z1[0] + z1[1] * z1[1]) + (z1[2] * z1[2] + z1[3] * z1[3]);
                    u32x4 w; w.x = cvt_pk_bf16(z0[0], z0[1]); w.y = cvt_pk_bf16(z0[2], z0[3]); w.z = cvt_pk_bf16(z1[0], z1[1]); w.w = cvt_pk_bf16(z1[2], z1[3]);
                    store16_wt(ob + off + bj * HALF, w);
                }
                s1 += __shfl_xor(s1, 16); s1 += __shfl_xor(s1, 32);
                s2 += __shfl_xor(s2, 16); s2 += __shfl_xor(s2, 32);
                if (fq == 0) { P1[(size_t)row * 16 + u.pn * 4 + wc] = s1; if (P2) P2[(size_t)row * 16 + u.pn * 4 + wc] = s2; }
            }
        }
    }
};

struct EpiFinal {
    static constexpr bool PERM = true;
    const bf16_t* rbuf; RowScaleSpec rsp; float alpha; const float* gf; float* out; float* xbuf; unsigned* cnt;
    __device__ __forceinline__ void operator()(f32x4 (&acc)[2][2][4][2], const Unit& u, int wr, int wc, int fr, int fq, LAS const float* rst) const {
        asm volatile("" : "+v"(fr), "+v"(fq));
        LAS float* tab = (LAS float*)((LAS unsigned char*)rst + 1024);
        LAS float* r3t = (LAS float*)((LAS unsigned char*)rst + 1024 + 4096);
        const int tid = opaque_tid();
        const int row0 = u.pm * BM + wr * 64 + fr, col0 = u.pn * BM + wc * 32 + 8 * fq;
        f32x4 g[2][2];
#pragma unroll
        for (int bj = 0; bj < 2; ++bj)
#pragma unroll
            for (int n = 0; n < 2; ++n) g[bj][n] = *(const f32x4*)(gf + col0 + bj * HALF + 4 * n);
#pragma unroll
        for (int ai = 0; ai < 2; ++ai) {
            bf16x8 rb[4][2];
#pragma unroll
            for (int m = 0; m < 4; ++m)
#pragma unroll
                for (int bj = 0; bj < 2; ++bj) rb[m][bj] = *(const bf16x8*)(rbuf + (size_t)(row0 + ai * HALF + m * 16) * DM + col0 + bj * HALF);
#pragma unroll
            for (int m = 0; m < 4; ++m) {
                float s1 = 0.f;
#pragma unroll
                for (int bj = 0; bj < 2; ++bj) {
                    const bf16x8 t = rb[m][bj];
                    const f32x4 i0 = (f32x4){bf2f(t[0]), bf2f(t[1]), bf2f(t[2]), bf2f(t[3])}, i1 = (f32x4){bf2f(t[4]), bf2f(t[5]), bf2f(t[6]), bf2f(t[7])};
                    const f32x4 h0 = i0 + acc[ai][bj][m][0] * alpha, h1 = i1 + acc[ai][bj][m][1] * alpha;
                    s1 += (h0[0] * h0[0] + h0[1] * h0[1]) + (h0[2] * h0[2] + h0[3] * h0[3]) + (h1[0] * h1[0] + h1[1] * h1[1]) + (h1[2] * h1[2] + h1[3] * h1[3]);
                    acc[ai][bj][m][0] = h0 * g[bj][0]; acc[ai][bj][m][1] = h1 * g[bj][1];
                }
                s1 += __shfl_xor(s1, 16); s1 += __shfl_xor(s1, 32);
                if (fq == 0) tab[(ai * HALF + wr * 64 + m * 16 + fr) * 4 + wc] = s1;
            }
        }
        asm volatile("s_waitcnt lgkmcnt(0)" ::: "memory"); __builtin_amdgcn_s_barrier(); asm volatile("" ::: "memory");
        if (tid < BM) {
            const float ts = (tab[tid * 4 + 0] + tab[tid * 4 + 1]) + (tab[tid * 4 + 2] + tab[tid * 4 + 3]);
            __hip_atomic_store(xbuf + (size_t)(u.pm * BM + tid) * 4 + u.pn, ts, __ATOMIC_RELAXED, __HIP_MEMORY_SCOPE_AGENT);
        }
        asm volatile("s_waitcnt vmcnt(0) lgkmcnt(0)" ::: "memory"); __builtin_amdgcn_s_barrier(); asm volatile("" ::: "memory");
        if (tid == 0) {
            unsigned* c = cnt + 64 * u.pm;
            (void)xb_add(c, 1u);
            unsigned sp = 0;
            while (xb_ld(c) < 4u) { __builtin_amdgcn_s_sleep(1); if (++sp > (1u << 22)) break; }
            __builtin_amdgcn_fence(__ATOMIC_ACQUIRE, "agent");
            asm volatile("s_waitcnt vmcnt(0)" ::: "memory");
        }
        asm volatile("s_waitcnt lgkmcnt(0)" ::: "memory"); __builtin_amdgcn_s_barrier(); asm volatile("" ::: "memory");
        if (tid < BM) {
            const float* xr = xbuf + (size_t)(u.pm * BM + tid) * 4;
            const float t0 = __hip_atomic_load(xr + 0, __ATOMIC_RELAXED, __HIP_MEMORY_SCOPE_AGENT), t1 = __hip_atomic_load(xr + 1, __ATOMIC_RELAXED, __HIP_MEMORY_SCOPE_AGENT);
            const float t2 = __hip_atomic_load(xr + 2, __ATOMIC_RELAXED, __HIP_MEMORY_SCOPE_AGENT), t3 = __hip_atomic_load(xr + 3, __ATOMIC_RELAXED, __HIP_MEMORY_SCOPE_AGENT);
            r3t[tid] = __builtin_amdgcn_rsqf(((t0 + t1) + (t2 + t3)) * (1.0f / DM) + EPS);
        }
        asm volatile("s_waitcnt vmcnt(0) lgkmcnt(0)" ::: "memory"); __builtin_amdgcn_s_barrier(); asm volatile("" ::: "memory");
#pragma unroll
        for (int ai = 0; ai < 2; ++ai)
#pragma unroll
            for (int m = 0; m < 4; ++m) {
                const float r3 = r3t[ai * HALF + wr * 64 + m * 16 + fr];
                float* orow = out + (size_t)(row0 + ai * HALF + m * 16) * DM + col0;
#pragma unroll
                for (int bj = 0; bj < 2; ++bj) { *(f32x4*)(orow + bj * HALF) = acc[ai][bj][m][0] * r3; *(f32x4*)(orow + bj * HALF + 4) = acc[ai][bj][m][1] * r3; }
            }
    }
};

template <class Epi, class Sched, bool ALIGN_EPI, bool SP2 = PG8_SP2_DEFAULT>
__device__ __forceinline__ void gemm_phase(LAS unsigned char* lds, const Gemm g, const Sched& S, const Epi& E) {
    const int tid = opaque_tid(), wid = __builtin_amdgcn_readfirstlane(tid >> 6), lane = tid & 63, wr = wid >> 2, wc = wid & 3, fr = lane & 15, fq = lane >> 4;
    const int K = g.K, nt = K / BK;
    unsigned voffA[2], voffB[2];
#pragma unroll
    for (int i = 0; i < 2; ++i) { int R, C; stage_rc(tid * 16 + i * 8192, R, C); const int Rb = Epi::PERM ? ((R & ~31) + perm32(R & 31)) : R;
        voffA[i] = (unsigned)(R * K + C) * 2u; voffB[i] = (unsigned)(Rb * K + C) * 2u; }
    const size_t kstep = (size_t)(BK * 2);
    const size_t hstep = (size_t)HALF * K * 2;
    const size_t tstep = 2 * hstep;
    const unsigned ldsw = (unsigned)wid * 1024u;
    const int aoff = lds_byte(wr * 64 + fr, fq * 8), boff = lds_byte(wc * 32 + fr, fq * 8);
#define PG8_SA(b, h) (((b) * 2 + (h)) * HTB)
#define PG8_SB(b, h) ((4 + (b) * 2 + (h)) * HTB)
#define PG8_STAGE(bufoff, gbase, voff) do { _Pragma("unroll") for (int _i = 0; _i < 2; ++_i) \
        __builtin_amdgcn_global_load_lds((const unsigned*)((const char*)(gbase) + (voff)[_i]), (LAS unsigned*)(lds + (bufoff) + ldsw + _i * 8192), 16, 0, 0); } while (0)
#define PG8_LDA(dst, b, h) do { _Pragma("unroll") for (int m = 0; m < 4; ++m) _Pragma("unroll") for (int k = 0; k < 2; ++k) dst[m][k] = *(const LAS bf16x8*)(lds + PG8_SA(b, h) + aoff + m * 2048 + k * 1024); } while (0)
#define PG8_LDB(dst, b, h) do { _Pragma("unroll") for (int n = 0; n < 2; ++n) _Pragma("unroll") for (int k = 0; k < 2; ++k) dst[n][k] = *(const LAS bf16x8*)(lds + PG8_SB(b, h) + boff + n * 2048 + k * 1024); } while (0)
#define PG8_MMA(ai, bj, At, Bt) do { __builtin_amdgcn_s_setprio(1); _Pragma("unroll") for (int m = 0; m < 4; ++m) _Pragma("unroll") for (int n = 0; n < 2; ++n) _Pragma("unroll") for (int k = 0; k < 2; ++k) \
        acc[ai][bj][m][n] = __builtin_amdgcn_mfma_f32_16x16x32_bf16(Bt[n][k], At[m][k], acc[ai][bj][m][n], 0, 0, 0); __builtin_amdgcn_s_setprio(0); } while (0)
#define PG8_WAIT_V(n) asm volatile("s_waitcnt vmcnt(" #n ")" ::: "memory")
#define PG8_WAIT_L(n) asm volatile("s_waitcnt lgkmcnt(" #n ")" ::: "memory")
#define PG8_BAR __builtin_amdgcn_s_barrier()
#define PG8_SCHED __builtin_amdgcn_sched_barrier(0)
    Unit cur, nxt; int ui = 0;
    if (!S.next(0, cur)) return;
    f32x4 acc[2][2][4][2];
#pragma unroll
    for (int a = 0; a < 2; ++a)
#pragma unroll
        for (int b = 0; b < 2; ++b)
#pragma unroll
            for (int m = 0; m < 4; ++m)
#pragma unroll
                for (int n = 0; n < 2; ++n) acc[a][b][m][n] = (f32x4){0.f, 0.f, 0.f, 0.f};
    bf16x8 At[4][2], B0[2][2], B1[2][2];
    const char* cA = (const char*)g.A + (size_t)cur.pm * tstep; const char* cB = (const char*)g.Bt + (size_t)cur.pn * tstep;
    LAS float* rst = (LAS float*)(lds + LDS_RS_OFF);
    const RowScaleSpec rsp = E.rsp; const bool rs_ld = (rsp.useA | rsp.withB) != 0;
    f32x4 pa0 = {0.f, 0.f, 0.f, 0.f}, pa1 = pa0, pb0 = pa0, pb1 = pa0;
    if (rs_ld) { const size_t o = (size_t)(cur.pm * BM + (tid >> 1)) * 16 + (tid & 1) * 8;
        pa0 = *(const f32x4*)(rsp.PA + o); pa1 = *(const f32x4*)(rsp.PA + o + 4);
        if (rsp.withB) { pb0 = *(const f32x4*)(rsp.PB + o); pb1 = *(const f32x4*)(rsp.PB + o + 4); } }
    if constexpr (SP2) { PG8_STAGE(PG8_SB(0, 0), cB, voffB); PG8_STAGE(PG8_SB(0, 1), cB + hstep, voffB); PG8_STAGE(PG8_SA(0, 0), cA, voffA); PG8_STAGE(PG8_SA(0, 1), cA + hstep, voffA); }
    else { PG8_STAGE(PG8_SB(0, 0), cB, voffB); PG8_STAGE(PG8_SA(0, 0), cA, voffA); PG8_STAGE(PG8_SB(0, 1), cB + hstep, voffB); PG8_STAGE(PG8_SA(0, 1), cA + hstep, voffA); }
    {
        float sa = ((pa0[0] + pa0[1]) + (pa0[2] + pa0[3])) + ((pa1[0] + pa1[1]) + (pa1[2] + pa1[3])); sa += __shfl_xor(sa, 1);
        float sb = ((pb0[0] + pb0[1]) + (pb0[2] + pb0[3])) + ((pb1[0] + pb1[1]) + (pb1[2] + pb1[3])); sb += __shfl_xor(sb, 1);
        float r = rsp.useA ? __builtin_amdgcn_rsqf(sa * (1.0f / DM) + EPS) : 1.0f;
        if (rsp.withB) r = r * __builtin_amdgcn_rsqf(r * r * sb * (1.0f / DM) + EPS);
        if ((tid & 1) == 0) rst[tid >> 1] = r;
    }
    if (wr == 1) PG8_BAR;
    if constexpr (SP2) { PG8_WAIT_V(2); } else { PG8_WAIT_V(4); } PG8_BAR;
    PG8_STAGE(PG8_SB(1, 0), cB + kstep, voffB); PG8_STAGE(PG8_SA(1, 0), cA + kstep, voffA); PG8_STAGE(PG8_SB(1, 1), cB + hstep + kstep, voffB);
    PG8_WAIT_V(6); PG8_BAR;
    for (;;) {
        const bool has_next = S.next(ui + 1, nxt);
        const char* nA = has_next ? (const char*)g.A + (size_t)nxt.pm * tstep : cA; const char* nB = has_next ? (const char*)g.Bt + (size_t)nxt.pn * tstep : cB;
        for (int t = 0; t < nt; t += 2) {
            const bool last = (t == nt - 2);
            const char* a1 = cA + (size_t)(t + 1) * kstep;
            const char* a2 = last ? nA : cA + (size_t)(t + 2) * kstep; const char* b2 = last ? nB : cB + (size_t)(t + 2) * kstep;
            const char* a3 = a2 + kstep; const char* b3 = b2 + kstep;
            if constexpr (SP2) {
            PG8_LDB(B0, 0, 0); PG8_LDB(B1, 0, 1); PG8_SCHED; PG8_LDA(At, 0, 0); PG8_STAGE(PG8_SA(1, 1), a1 + hstep, voffA);
            PG8_WAIT_V(8); PG8_WAIT_L(0); PG8_BAR; PG8_MMA(0, 0, At, B0); PG8_MMA(0, 1, At, B1); PG8_BAR; PG8_SCHED;
            PG8_LDA(At, 0, 1); PG8_STAGE(PG8_SB(0, 0), b2, voffB); PG8_STAGE(PG8_SB(0, 1), b2 + hstep, voffB); PG8_STAGE(PG8_SA(0, 0), a2, voffA);
            PG8_WAIT_V(8); PG8_WAIT_L(0); PG8_BAR; PG8_MMA(1, 0, At, B0); PG8_MMA(1, 1, At, B1); PG8_BAR; PG8_SCHED;
            PG8_LDB(B0, 1, 0); PG8_LDB(B1, 1, 1); PG8_SCHED; PG8_LDA(At, 1, 0); PG8_STAGE(PG8_SA(0, 1), a2 + hstep, voffA);
            PG8_WAIT_V(8); PG8_WAIT_L(0); PG8_BAR; PG8_MMA(0, 0, At, B0); PG8_MMA(0, 1, At, B1); PG8_BAR; PG8_SCHED;
            PG8_LDA(At, 1, 1); PG8_STAGE(PG8_SB(1, 0), b3, voffB); PG8_STAGE(PG8_SB(1, 1), b3 + hstep, voffB); PG8_STAGE(PG8_SA(1, 0), a3, voffA);
            PG8_WAIT_V(8); PG8_WAIT_L(0); PG8_BAR; PG8_MMA(1, 0, At, B0); PG8_MMA(1, 1, At, B1); PG8_BAR; PG8_SCHED;
            } else {
            PG8_LDB(B0, 0, 0); PG8_SCHED; PG8_LDA(At, 0, 0); PG8_STAGE(PG8_SA(1, 1), a1 + hstep, voffA);
            PG8_WAIT_L(8); PG8_BAR; PG8_WAIT_L(0); PG8_MMA(0, 0, At, B0); PG8_BAR; PG8_SCHED;
            PG8_LDB(B1, 0, 1); PG8_STAGE(PG8_SB(0, 0), b2, voffB);
            PG8_BAR; PG8_WAIT_L(0); PG8_MMA(0, 1, At, B1); PG8_BAR;
            PG8_LDA(At, 0, 1); PG8_STAGE(PG8_SA(0, 0), a2, voffA);
            PG8_BAR; PG8_WAIT_L(0); PG8_MMA(1, 0, At, B0); PG8_BAR; PG8_SCHED;
            PG8_STAGE(PG8_SB(0, 1), b2 + hstep, voffB);
            PG8_WAIT_V(6); PG8_BAR; PG8_MMA(1, 1, At, B1); PG8_BAR;
            PG8_LDB(B0, 1, 0); PG8_SCHED; PG8_LDA(At, 1, 0); PG8_STAGE(PG8_SA(0, 1), a2 + hstep, voffA);
            PG8_WAIT_L(8); PG8_BAR; PG8_WAIT_L(0); PG8_MMA(0, 0, At, B0); PG8_BAR; PG8_SCHED;
            PG8_LDB(B1, 1, 1); PG8_STAGE(PG8_SB(1, 0), b3, voffB);
            PG8_BAR; PG8_WAIT_L(0); PG8_MMA(0, 1, At, B1); PG8_BAR;
            PG8_LDA(At, 1, 1); PG8_STAGE(PG8_SA(1, 0), a3, voffA);
            PG8_BAR; PG8_WAIT_L(0); PG8_MMA(1, 0, At, B0); PG8_BAR; PG8_SCHED;
            PG8_STAGE(PG8_SB(1, 1), b3 + hstep, voffB);
            PG8_WAIT_V(6); PG8_BAR; PG8_MMA(1, 1, At, B1); PG8_BAR;
            }
        }
        if constexpr (ALIGN_EPI) { if (wr == 0) PG8_BAR; }
        E(acc, cur, wr, wc, fr, fq, rst);
        if (!has_next) break;
        if (nxt.pm != cur.pm) __builtin_trap();
#pragma unroll
        for (int a = 0; a < 2; ++a)
#pragma unroll
            for (int b = 0; b < 2; ++b)
#pragma unroll
                for (int m = 0; m < 4; ++m)
#pragma unroll
                    for (int n = 0; n < 2; ++n) acc[a][b][m][n] = (f32x4){0.f, 0.f, 0.f, 0.f};
        cur = nxt; cA = nA; cB = nB; ++ui;
        if constexpr (ALIGN_EPI) { if (wr == 1) PG8_BAR; }
    }
    PG8_WAIT_V(0);
    if constexpr (!ALIGN_EPI) { if (wr == 0) PG8_BAR; }
    PG8_BAR;
#undef PG8_SA
#undef PG8_SB
#undef PG8_STAGE
#undef PG8_LDA
#undef PG8_LDB
#undef PG8_MMA
#undef PG8_WAIT_V
#undef PG8_WAIT_L
#undef PG8_BAR
#undef PG8_SCHED
}
}

struct Params {
    const float* x; const float* mem; const int* pos;
    const float* ffn1_norm; const float* ffn1_w1; const float* ffn1_w3; const float* ffn1_w2;
    const float* mix_norm; const float* w_in; const float* conv_w; const float* conv_b; const float* conv_ln_g; const float* conv_ln_b;
    const float* swa_q_norm; const float* swa_k_norm; const float* swa_sinks;
    const float* mem_norm; const float* w_mem_kv; const float* mem_q_norm; const float* mem_k_norm; const float* w_out;
    const float* ffn2_norm; const float* ffn2_w1; const float* ffn2_w3; const float* ffn2_w2; const float* final_norm;
    float* out; unsigned char* ws;
};

typedef const __attribute__((address_space(4))) Params* KP;
__device__ __forceinline__ KP kparams() { KP q = (KP)__builtin_amdgcn_kernarg_segment_ptr(); asm volatile("" : "+s"(q)); return q; }

#define XB_TMO      128
#define XB_XCNT(j)  (256  + 64 * (j))
#define XB_XSUB(j)  (1280 + 64 * (j))
#define XB_XGEN(j)  (2304 + 64 * (j))
#define XB_TOP      3328
#define XB_TOPGEN   3392
#define XCD_BAR_WORDS 3456
#define XB_SPIN_CAP (1u << 20)
__device__ __forceinline__ unsigned xb_ld(unsigned* p)              { return __hip_atomic_load(p, __ATOMIC_RELAXED, __HIP_MEMORY_SCOPE_AGENT); }
__device__ __forceinline__ unsigned xb_add(unsigned* p, unsigned v) { return __hip_atomic_fetch_add(p, v, __ATOMIC_RELAXED, __HIP_MEMORY_SCOPE_AGENT); }
__device__ __forceinline__ unsigned xb_xcc_id() { return (unsigned)__builtin_amdgcn_s_getreg((3 << 11) | 20) & 0xFu; }
#define XB_SPIN(cond, bar) do { unsigned _sp = 0; while (cond) { __builtin_amdgcn_s_sleep(1); \
    if ((++_sp & 255u) == 0u) { if (xb_ld(&(bar)[XB_TMO])) break; if (_sp > XB_SPIN_CAP) { atomicAdd(&(bar)[XB_TMO], 1u); break; } } } } while (0)
__device__ __forceinline__ void xcd_barrier_complete(unsigned* bar, unsigned x, unsigned& nloc, unsigned& nx) {
    const unsigned G = gridDim.x * gridDim.y * gridDim.z;
    unsigned sum, cnt, mine, sp = 0u;
    for (;;) {
        sum = 0u; cnt = 0u; mine = 0u;
#pragma unroll
        for (unsigned j = 0; j < 16; ++j) { const unsigned c = xb_ld(&bar[XB_XCNT(j)]); sum += c; cnt += (c > 0u) ? 1u : 0u; mine = (j == x) ? c : mine; }
        if (sum == G) break;
        __builtin_amdgcn_s_sleep(1);
        if ((++sp & 255u) == 0u) { if (xb_ld(&bar[XB_TMO])) break; if (sp > XB_SPIN_CAP) { atomicAdd(&bar[XB_TMO], 1u); break; } }
    }
    nloc = mine > 0u ? mine : 1u; nx = cnt > 0u ? cnt : 1u;
}
__device__ __forceinline__ void xcd_barrier(LAS unsigned char* lds) {
    asm volatile("s_waitcnt vmcnt(0)" ::: "memory");
    __syncthreads();
    if (opaque_tid() == 0) {
        unsigned* bar = (unsigned*)(kparams()->ws + WS_CTL);
        volatile LAS unsigned* st = (volatile LAS unsigned*)(lds + LDS_MISC);
        const unsigned x = xb_xcc_id();
        __builtin_amdgcn_s_waitcnt(0);
        unsigned nloc = st[0], nx = st[1];
        if (nloc == 0u) { xcd_barrier_complete(bar, x, nloc, nx); st[0] = nloc; st[1] = nx; }
        const unsigned old = xb_add(&bar[XB_XSUB(x)], 1u);
        const unsigned gen = old / nloc;
        if (old + 1u == (gen + 1u) * nloc) {
            __builtin_amdgcn_fence(__ATOMIC_RELEASE, "agent");
            asm volatile("s_waitcnt vmcnt(0)" ::: "memory");
            const unsigned og = xb_add(&bar[XB_TOP], 1u);
            const unsigned tg = og / nx;
            if (og + 1u == (tg + 1u) * nx) xb_add(&bar[XB_TOPGEN], 1u);
            else XB_SPIN(xb_ld(&bar[XB_TOPGEN]) == tg, bar);
            __builtin_amdgcn_fence(__ATOMIC_ACQUIRE, "agent");
            xb_add(&bar[XB_XGEN(x)], 1u);
            asm volatile("s_waitcnt vmcnt(0)" ::: "memory");
        } else {
            XB_SPIN(xb_ld(&bar[XB_XGEN(x)]) == gen, bar);
            __builtin_amdgcn_fence(__ATOMIC_ACQUIRE, "agent");
            asm volatile("s_waitcnt vmcnt(0)" ::: "memory");
        }
    }
    __syncthreads();
}

constexpr int TR_L_ITEMS = 704 * 6 + 416 + 256 + 128, TR_ITEMS = DEPTH * TR_L_ITEMS;
struct TrDesc { const float* W; bf16_t* WT; const float* gain; int K, N, il, row_off, item; };
constexpr int TR_L_MAIN = TR_L_ITEMS - 128;
__device__ __forceinline__ TrDesc tr_desc(KP pp, int l, int r) {
    unsigned char* ws = pp->ws; unsigned char* wl = ws + WS_W + (size_t)l * SZ_LAYER;
    const size_t o13 = (size_t)l * DM * DFF;
    TrDesc d;
    if (r < 704) { d = TrDesc{pp->ffn1_w1 + o13, (bf16_t*)(wl + OFF_W13A), pp->ffn1_norm + l * DM, DM, DFF, 1, 0, r}; return d; } r -= 704;
    if (r < 704) { d = TrDesc{pp->ffn1_w3 + o13, (bf16_t*)(wl + OFF_W13A), pp->ffn1_norm + l * DM, DM, DFF, 1, 128, r}; return d; } r -= 704;
    if (r < 704) { d = TrDesc{pp->ffn1_w2 + o13, (bf16_t*)(wl + OFF_W2A), nullptr, DFF, DM, 0, 0, r}; return d; } r -= 704;
    if (r < 416) { d = TrDesc{pp->w_in + (size_t)l * DM * DIN, (bf16_t*)(wl + OFF_WIN), pp->mix_norm + l * DM, DM, DIN, 0, 0, r}; return d; } r -= 416;
    if (r < 256) { d = TrDesc{pp->w_out + (size_t)l * DM * DM, (bf16_t*)(wl + OFF_WOUT), nullptr, DM, DM, 0, 0, r}; return d; } r -= 256;
    if (r < 704) { d = TrDesc{pp->ffn2_w1 + o13, (bf16_t*)(wl + OFF_W13B), pp->ffn2_norm + l * DM, DM, DFF, 1, 0, r}; return d; } r -= 704;
    if (r < 704) { d = TrDesc{pp->ffn2_w3 + o13, (bf16_t*)(wl + OFF_W13B), pp->ffn2_norm + l * DM, DM, DFF, 1, 128, r}; return d; } r -= 704;
    if (r < 704) { d = TrDesc{pp->ffn2_w2 + o13, (bf16_t*)(wl + OFF_W2B), nullptr, DFF, DM, 0, 0, r}; return d; } r -= 704;
    d = TrDesc{pp->w_mem_kv + (size_t)l * DM * 512, (bf16_t*)(ws + WS_WM), pp->mem_norm + l * DM, DM, 512, 0, l * 512, r}; return d;
}
__device__ __forceinline__ void tr_load(const TrDesc& d, int lane, f32x4 (&v)[16]) {
    const int nblk = d.N >> 6, kb = d.item / nblk, nb = d.item - kb * nblk;
    const float* src = d.W + (size_t)(64 * kb + 16 * (lane >> 4)) * d.N + 64 * nb + 4 * (lane & 15);
#pragma unroll
    for (int i = 0; i < 16; ++i) v[i] = __builtin_nontemporal_load((const f32x4*)(src + (size_t)i * d.N));
}
__device__ __forceinline__ void tr_store(const TrDesc& d, int lane, f32x4 (&v)[16]) {
    const int nblk = d.N >> 6, kb = d.item / nblk, nb = d.item - kb * nblk, kk = 64 * kb + 16 * (lane >> 4), nn = 64 * nb + 4 * (lane & 15);
    if (d.gain) {
#pragma unroll
        for (int q = 0; q < 4; ++q) { const f32x4 gq = *(const f32x4*)(d.gain + kk + 4 * q);
#pragma unroll
            for (int e = 0; e < 4; ++e) v[4 * q + e] = v[4 * q + e] * gq[e]; }
    }
#pragma unroll
    for (int j = 0; j < 4; ++j) {
        const int n = nn + j, drow = d.row_off + (d.il ? (((n >> 7) << 8) + (n & 127)) : n);
        u32x4 a, b;
        a.x = cvt_pk_bf16(v[0][j], v[1][j]); a.y = cvt_pk_bf16(v[2][j], v[3][j]); a.z = cvt_pk_bf16(v[4][j], v[5][j]); a.w = cvt_pk_bf16(v[6][j], v[7][j]);
        b.x = cvt_pk_bf16(v[8][j], v[9][j]); b.y = cvt_pk_bf16(v[10][j], v[11][j]); b.z = cvt_pk_bf16(v[12][j], v[13][j]); b.w = cvt_pk_bf16(v[14][j], v[15][j]);
        u32x4* o = (u32x4*)(d.WT + (size_t)drow * d.K + kk);
        store16_wt(o, a); store16_wt(o + 1, b);
    }
}
__device__ __forceinline__ float row_to_bf16(const float* xrow, bf16_t* orow, int lane) {
    const f32x4* xr = (const f32x4*)xrow + lane; float s = 0.f; f32x4 v[4];
#pragma unroll
    for (int j = 0; j < 4; ++j) { v[j] = xr[64 * j]; s += (v[j][0] * v[j][0] + v[j][1] * v[j][1]) + (v[j][2] * v[j][2] + v[j][3] * v[j][3]); }
    u32x2* o8 = (u32x2*)orow + lane;
#pragma unroll
    for (int j = 0; j < 4; ++j) { u32x2 w; w.x = cvt_pk_bf16(v[j][0], v[j][1]); w.y = cvt_pk_bf16(v[j][2], v[j][3]); o8[64 * j] = w; }
    return wave_sum(s);
}

__device__ __forceinline__ void convert_items(KP pp, int l, int r0, int r1, int gw, int NGW, int lane) {
    int g = r0 + gw; TrDesc d; f32x4 v[16];
    if (g >= r1) return;
    d = tr_desc(pp, l, g); tr_load(d, lane, v);
#pragma unroll 1
    while (g < r1) {
        const int gn = g + NGW; TrDesc dn = d; f32x4 vn[16];
        if (gn < r1) { dn = tr_desc(pp, l, gn); tr_load(dn, lane, vn); }
        else {
#pragma unroll
            for (int i = 0; i < 16; ++i) vn[i] = v[i];
        }
        tr_store(d, lane, v);
#pragma unroll
        for (int i = 0; i < 16; ++i) v[i] = vn[i];
        d = dn; g = gn;
    }
}
__device__ __forceinline__ void convert_in_tail(int lnext, int kmin, int f0, int f1, int skip_last = 0) {
    if (lnext >= DEPTH) return;
    const int bid = opaque_bid(), j = bid >> 3, k = j >> 3;
    if (k < kmin || j >= 32 - skip_last) return;
    const KP pp = kparams();
    const int tid = opaque_tid(), lane = tid & 63, wave = tid >> 6;
    const int cidx = (j - 8 * kmin) * 8 + (bid & 7), ncu = (4 - kmin) * 64 - 8 * skip_last;
    convert_items(pp, lnext, TR_L_MAIN * f0 / 16, TR_L_MAIN * f1 / 16, cidx * 8 + wave, ncu * 8, lane);
}
__device__ __forceinline__ void prologue(LAS unsigned char* lds) {
    const KP pp = kparams();
    const int tid = opaque_tid(), lane = tid & 63, wave = tid >> 6;
    const int G = gridDim.x, gw = blockIdx.x * 8 + wave, NGW = G * 8;
    unsigned char* ws = pp->ws;
    convert_items(pp, 0, 0, TR_L_ITEMS, gw, NGW, lane);
#pragma unroll 1
    for (int l = 1; l < DEPTH; ++l) {
        const int shift = (TR_L_ITEMS + 128 * (l - 1)) % NGW;
        convert_items(pp, l, TR_L_MAIN, TR_L_ITEMS, (gw + NGW - shift) % NGW, NGW, lane);
    }
#pragma unroll 1
    for (int l = 0; l < DEPTH; ++l) {
        unsigned char* wl = ws + WS_W + (size_t)l * SZ_LAYER;
        u32x4* z = (u32x4*)(wl + OFF_WIN + (size_t)DIN * DM * 2); const int n16 = (DINP - DIN) * DM * 2 / 16;
        for (int i = blockIdx.x * 512 + tid; i < n16; i += G * 512) z[i] = (u32x4){0u, 0u, 0u, 0u};
    }
    {
        bf16_t* RB = (bf16_t*)(ws + WS_RB); float* PB = (float*)(ws + WS_PB);
        for (int m0 = gw * 4; m0 < M; m0 += NGW * 4) {
            f32x4 v[4][4];
#pragma unroll
            for (int r = 0; r < 4; ++r)
#pragma unroll
                for (int j = 0; j < 4; ++j) v[r][j] = __builtin_nontemporal_load((const f32x4*)(pp->x + (size_t)(m0 + r) * DM) + lane + 64 * j);
#pragma unroll
            for (int r = 0; r < 4; ++r) {
                float sq = 0.f; u32x2* o8 = (u32x2*)(RB + (size_t)(m0 + r) * DM) + lane;
#pragma unroll
                for (int j = 0; j < 4; ++j) { const f32x4 t = v[r][j]; sq += (t[0] * t[0] + t[1] * t[1]) + (t[2] * t[2] + t[3] * t[3]);
                    u32x2 w; w.x = cvt_pk_bf16(t[0], t[1]); w.y = cvt_pk_bf16(t[2], t[3]); o8[64 * j] = w; }
                sq = wave_sum(sq);
                if (lane < 16) PB[(size_t)(m0 + r) * 16 + lane] = lane == 0 ? sq : 0.f;
            }
        }
        bf16_t* MB = (bf16_t*)(ws + WS_MEMB); float* PM = (float*)(ws + WS_PM);
        for (int m = gw; m < MROWS; m += NGW) { const float s = row_to_bf16(pp->mem + (size_t)m * DM, MB + (size_t)m * DM, lane); if (lane < 16) PM[(size_t)m * 16 + lane] = lane == 0 ? s : 0.f; }
    }
}

constexpr int KS_STRIDE = 144, VT_STRIDE = 544;
constexpr int LDS_KS = 0, LDS_VT = 256 * KS_STRIDE;
constexpr float QSCALE = 0.125f * 1.4426950408889634f;

struct RowTask { bf16x8 lo, hi; int pos; };
template <bool ROPE>
__device__ __forceinline__ void row_issue(RowTask& t, const bf16_t* rowp, const int* posp, int c) {
    t.lo = *(const bf16x8*)(rowp + 8 * c); t.hi = *(const bf16x8*)(rowp + 32 + 8 * c);
    if (ROPE) t.pos = *posp;
}
__device__ __forceinline__ void rope_freqs(int c, float (&f)[8]) {
#pragma unroll
    for (int e = 0; e < 8; ++e) f[e] = __builtin_amdgcn_exp2f(-(float)(8 * c + e) * (13.287712379549449f / 32.0f)) * 0.15915494309189535f;
}
template <bool ROPE>
__device__ __forceinline__ void row_finish(const RowTask& t, bool valid, const f32x4 (&g)[4], const float (&rf)[8], float scale, int m1, int m2, u32x4& w1, u32x4& w2) {
    float x1[8], x2[8]; float ss = 0.f;
#pragma unroll
    for (int e = 0; e < 8; ++e) { x1[e] = valid ? bf2f(t.lo[e]) : 0.f; x2[e] = valid ? bf2f(t.hi[e]) : 0.f; ss += x1[e] * x1[e] + x2[e] * x2[e]; }
    ss += __shfl_xor(ss, m1); ss += __shfl_xor(ss, m2);
    const float rs = scale * __builtin_amdgcn_rsqf(ss * (1.0f / 64.0f) + EPS);
#pragma unroll
    for (int e = 0; e < 4; ++e) { x1[e] *= rs * g[0][e]; x1[4 + e] *= rs * g[1][e]; x2[e] *= rs * g[2][e]; x2[4 + e] *= rs * g[3][e]; }
    if (ROPE) {
        const float pf = (float)t.pos;
#pragma unroll
        for (int e = 0; e < 8; ++e) { const float rev = __builtin_amdgcn_fractf(pf * rf[e]); const float cc = __builtin_amdgcn_cosf(rev), sn = __builtin_amdgcn_sinf(rev);
            const float a = x1[e], b = x2[e]; x1[e] = a * cc - b * sn; x2[e] = b * cc + a * sn; }
    }
    w1.x = cvt_pk_bf16(x1[0], x1[1]); w1.y = cvt_pk_bf16(x1[2], x1[3]); w1.z = cvt_pk_bf16(x1[4], x1[5]); w1.w = cvt_pk_bf16(x1[6], x1[7]);
    w2.x = cvt_pk_bf16(x2[0], x2[1]); w2.y = cvt_pk_bf16(x2[2], x2[3]); w2.z = cvt_pk_bf16(x2[4], x2[5]); w2.w = cvt_pk_bf16(x2[6], x2[7]);
}
__device__ __forceinline__ void load_gains(const float* g, int c, f32x4 (&o)[4]) { o[0] = *(const f32x4*)(g + 8 * c); o[1] = *(const f32x4*)(g + 8 * c + 4); o[2] = *(const f32x4*)(g + 32 + 8 * c); o[3] = *(const f32x4*)(g + 36 + 8 * c); }
__device__ __forceinline__ void vt_store(LAS unsigned char* lds, bf16x8 v, bool valid, int r, int c) {
#pragma unroll
    for (int e = 0; e < 8; ++e) *(LAS short*)(lds + LDS_VT + (8 * c + e) * VT_STRIDE + 2 * r) = valid ? v[e] : (short)0;
}

template <int NT, bool SWA, int NQ>
__device__ __forceinline__ void attn_multi(LAS const unsigned char* lds, const bf16x8 (&q0)[NQ], const bf16x8 (&q1)[NQ], int kt0, int i0, bool first_blk, const float (&sink2)[NQ], bf16_t* const (&orow)[NQ], int fr, int fq) {
    f32x4 s[NQ][NT];
    {
        const LAS unsigned char* kp = lds + LDS_KS + (16 * kt0 + fr) * KS_STRIDE + 16 * fq;
        bf16x8 kc0 = *(const LAS bf16x8*)kp, kc1 = *(const LAS bf16x8*)(kp + 64);
#pragma unroll
        for (int t = 0; t < NT; ++t) {
            bf16x8 kn0 = kc0, kn1 = kc1;
            if (t + 1 < NT) { kn0 = *(const LAS bf16x8*)(kp + (t + 1) * 16 * KS_STRIDE); kn1 = *(const LAS bf16x8*)(kp + (t + 1) * 16 * KS_STRIDE + 64); }
#pragma unroll
            for (int n = 0; n < NQ; ++n) {
                f32x4 a = {0.f, 0.f, 0.f, 0.f};
                a = __builtin_amdgcn_mfma_f32_16x16x32_bf16(kc0, q0[n], a, 0, 0, 0);
                a = __builtin_amdgcn_mfma_f32_16x16x32_bf16(kc1, q1[n], a, 0, 0, 0);
                s[n][t] = a;
            }
            kc0 = kn0; kc1 = kn1;
        }
    }
    float l[NQ];
#pragma unroll
    for (int n = 0; n < NQ; ++n) {
        float mx = -INFINITY;
#pragma unroll
        for (int t = 0; t < NT; ++t)
#pragma unroll
            for (int j = 0; j < 4; ++j) {
                if (SWA) { const int kj = 16 * (kt0 + t) + 4 * fq + j, i = i0 + fr; const bool ok = (kj >= i + 1) && (kj <= i + 128) && (!first_blk || kj >= 128); if (!ok) s[n][t][j] = -INFINITY; }
                mx = fmaxf(mx, s[n][t][j]);
            }
        mx = fmaxf(mx, __shfl_xor(mx, 16)); mx = fmaxf(mx, __shfl_xor(mx, 32));
        float ls = 0.f;
#pragma unroll
        for (int t = 0; t < NT; ++t)
#pragma unroll
            for (int j = 0; j < 4; ++j) { const float pv = __builtin_amdgcn_exp2f(s[n][t][j] - mx); ls += pv; s[n][t][j] = pv; }
        ls += __shfl_xor(ls, 16); ls += __shfl_xor(ls, 32);
        if (SWA) ls += __builtin_amdgcn_exp2f(sink2[n] - mx);
        l[n] = ls;
    }
    f32x4 o[NQ][4];
#pragma unroll
    for (int n = 0; n < NQ; ++n)
#pragma unroll
        for (int dt = 0; dt < 4; ++dt) o[n][dt] = (f32x4){0.f, 0.f, 0.f, 0.f};
    constexpr int NSP = (NT + 1) / 2;
    const LAS unsigned char* vbase = lds + LDS_VT + fr * VT_STRIDE + 2 * (16 * kt0 + 4 * fq);
    u32x2 va[4][2], vn[4][2];
#pragma unroll
    for (int dt = 0; dt < 4; ++dt) { va[dt][0] = *(const LAS u32x2*)(vbase + 16 * dt * VT_STRIDE); va[dt][1] = *(const LAS u32x2*)(vbase + 16 * dt * VT_STRIDE + 32); }
#pragma unroll
    for (int sp = 0; sp < NSP; ++sp) {
        if (sp + 1 < NSP) {
#pragma unroll
            for (int dt = 0; dt < 4; ++dt) { vn[dt][0] = *(const LAS u32x2*)(vbase + 16 * dt * VT_STRIDE + 64 * (sp + 1)); vn[dt][1] = *(const LAS u32x2*)(vbase + 16 * dt * VT_STRIDE + 64 * (sp + 1) + 32); }
        }
        bf16x8 pb[NQ];
#pragma unroll
        for (int n = 0; n < NQ; ++n) {
            u32x4 pw; pw.x = cvt_pk_bf16(s[n][2 * sp][0], s[n][2 * sp][1]); pw.y = cvt_pk_bf16(s[n][2 * sp][2], s[n][2 * sp][3]);
            if (2 * sp + 1 < NT) { pw.z = cvt_pk_bf16(s[n][(2 * sp + 1) % NT][0], s[n][(2 * sp + 1) % NT][1]); pw.w = cvt_pk_bf16(s[n][(2 * sp + 1) % NT][2], s[n][(2 * sp + 1) % NT][3]); } else { pw.z = 0u; pw.w = 0u; }
            pb[n] = __builtin_bit_cast(bf16x8, pw);
        }
#pragma unroll
        for (int dt = 0; dt < 4; ++dt) {
            u32x4 vw; vw.x = va[dt][0].x; vw.y = va[dt][0].y; vw.z = va[dt][1].x; vw.w = va[dt][1].y;
            const bf16x8 vf = __builtin_bit_cast(bf16x8, vw);
#pragma unroll
            for (int n = 0; n < NQ; ++n) o[n][dt] = __builtin_amdgcn_mfma_f32_16x16x32_bf16(vf, pb[n], o[n][dt], 0, 0, 0);
        }
        if (sp + 1 < NSP) {
#pragma unroll
            for (int dt = 0; dt < 4; ++dt) { va[dt][0] = vn[dt][0]; va[dt][1] = vn[dt][1]; }
        }
    }
#pragma unroll
    for (int n = 0; n < NQ; ++n) {
        const float inv = __builtin_amdgcn_rcpf(l[n]);
#pragma unroll
        for (int dt = 0; dt < 4; ++dt) { u32x2 w; w.x = cvt_pk_bf16(o[n][dt][0] * inv, o[n][dt][1] * inv); w.y = cvt_pk_bf16(o[n][dt][2] * inv, o[n][dt][3] * inv); store8_wt(orow[n] + 16 * dt + 4 * fq, w); }
    }
}

__device__ __forceinline__ void swa_unit(LAS unsigned char* lds, int l, int unit) {
    const KP pp = kparams(); struct { unsigned char* ws; const float* swa_k_norm; const float* swa_q_norm; const float* swa_sinks; } p = {pp->ws, pp->swa_k_norm, pp->swa_q_norm, pp->swa_sinks};
    const int tid = opaque_tid(), lane = tid & 63, wave = tid >> 6, fr = lane & 15, fq = lane >> 4;
    const int kvh = unit & 1, blk = (unit >> 1) & 63, b = unit >> 7;
    const bf16_t* P = (const bf16_t*)(p.ws + WS_P); bf16_t* Y = (bf16_t*)(p.ws + WS_Y);
    const int* posv = pp->pos;
    const long row0 = (long)b * SEQ + (long)blk * 128 - 128;
    const int row_lo = blk == 0 ? 128 : 0;
    RowTask kt[2], qt[3]; bf16x8 vv[4]; f32x4 gk[4], gq[4]; float sink2[3];
    const int kc = tid & 3;
#pragma unroll
    for (int it = 0; it < 2; ++it) { const int r = (tid + it * 512) >> 2, rr = r < row_lo ? row_lo : r; const long m = row0 + rr;
        row_issue<true>(kt[it], P + m * DINP + PC_K + kvh * 64, posv + m, kc); }
#pragma unroll
    for (int it = 0; it < 4; ++it) { const int task = tid + it * 512, r = task & 255, c = task >> 8, rr = r < row_lo ? row_lo : r;
        vv[it] = *(const bf16x8*)(P + (row0 + rr) * DINP + PC_V + kvh * 64 + 8 * c); }
#pragma unroll
    for (int gi3 = 0; gi3 < 3; ++gi3) { const int gidx = wave + 8 * gi3, g = gidx >> 3, gi = gidx & 7, hq = kvh * 3 + g;
        const long tok = (long)b * SEQ + (long)blk * 128 + 16 * gi + fr;
        row_issue<true>(qt[gi3], P + tok * DINP + PC_Q + hq * 64, posv + tok, fq);
        sink2[gi3] = p.swa_sinks[l * 6 + hq] * 1.4426950408889634f; }
    load_gains(p.swa_k_norm + l * 64, kc, gk); load_gains(p.swa_q_norm + l * 64, fq, gq);
    float rfk[8], rfq[8]; rope_freqs(kc, rfk); rope_freqs(fq, rfq);
#pragma unroll
    for (int it = 0; it < 2; ++it) { const int r = (tid + it * 512) >> 2; u32x4 w1, w2;
        row_finish<true>(kt[it], r >= row_lo, gk, rfk, 1.0f, 1, 2, w1, w2);
        *(LAS u32x4*)(lds + LDS_KS + r * KS_STRIDE + 16 * kc) = w1; *(LAS u32x4*)(lds + LDS_KS + r * KS_STRIDE + 64 + 16 * kc) = w2; }
#pragma unroll
    for (int it = 0; it < 4; ++it) { const int task = tid + it * 512, r = task & 255, c = task >> 8; vt_store(lds, vv[it], r >= row_lo, r, c); }
    if (tid < 128) { const unsigned z = opaque_zero(); *(LAS u32x4*)(lds + LDS_VT + (tid >> 1) * VT_STRIDE + 512 + 16 * (tid & 1)) = (u32x4){z, z, z, z}; }
    bf16x8 q0[3], q1[3];
#pragma unroll
    for (int gi3 = 0; gi3 < 3; ++gi3) { u32x4 w1, w2; row_finish<true>(qt[gi3], true, gq, rfq, QSCALE, 16, 32, w1, w2); q0[gi3] = __builtin_bit_cast(bf16x8, w1); q1[gi3] = __builtin_bit_cast(bf16x8, w2); }
    __syncthreads();
    {
        const long tok = (long)b * SEQ + (long)blk * 128 + 16 * wave + fr;
        bf16_t* const orow[3] = {Y + tok * DM + YC_SWA + (kvh * 3 + 0) * 64, Y + tok * DM + YC_SWA + (kvh * 3 + 1) * 64, Y + tok * DM + YC_SWA + (kvh * 3 + 2) * 64};
        attn_multi<9, true, 3>(lds, q0, q1, wave, 16 * wave, blk == 0, sink2, orow, fr, fq);
    }
    __syncthreads();
}
__device__ __forceinline__ void mem_unit(LAS unsigned char* lds, int l, int unit) {
    const KP pp = kparams(); struct { unsigned char* ws; const float* mem_k_norm; const float* mem_q_norm; } p = {pp->ws, pp->mem_k_norm, pp->mem_q_norm};
    const int tid = opaque_tid(), lane = tid & 63, wave = tid >> 6, fr = lane & 15, fq = lane >> 4;
    const int h = unit & 3, blk = (unit >> 2) & 31, b = unit >> 7;
    const bf16_t* P = (const bf16_t*)(p.ws + WS_P); bf16_t* Y = (bf16_t*)(p.ws + WS_Y);
    const bf16_t* MKV = (const bf16_t*)(p.ws + WS_MKV) + (long)b * MEMLEN * 2048 + l * 512 + h * 64;
    RowTask kt[2], qt[2]; bf16x8 vv[4]; f32x4 gk[4], gq[4];
    const int kc = tid & 3;
#pragma unroll
    for (int it = 0; it < 2; ++it) { const int r = (tid + it * 512) >> 2; row_issue<false>(kt[it], MKV + (long)r * 2048, nullptr, kc); }
#pragma unroll
    for (int it = 0; it < 4; ++it) { const int task = tid + it * 512, r = task & 255, c = task >> 8; vv[it] = *(const bf16x8*)(MKV + (long)r * 2048 + 256 + 8 * c); }
#pragma unroll
    for (int g2 = 0; g2 < 2; ++g2) { const long tok = (long)b * SEQ + (long)blk * 256 + 16 * (wave + 8 * g2) + fr; row_issue<false>(qt[g2], P + tok * DINP + PC_QM + h * 64, nullptr, fq); }
    load_gains(p.mem_k_norm + l * 64, kc, gk); load_gains(p.mem_q_norm + l * 64, fq, gq);
    const float rf0[8] = {0.f, 0.f, 0.f, 0.f, 0.f, 0.f, 0.f, 0.f};
#pragma unroll
    for (int it = 0; it < 2; ++it) { const int r = (tid + it * 512) >> 2; u32x4 w1, w2;
        row_finish<false>(kt[it], true, gk, rf0, 1.0f, 1, 2, w1, w2);
        *(LAS u32x4*)(lds + LDS_KS + r * KS_STRIDE + 16 * kc) = w1; *(LAS u32x4*)(lds + LDS_KS + r * KS_STRIDE + 64 + 16 * kc) = w2; }
#pragma unroll
    for (int it = 0; it < 4; ++it) { const int task = tid + it * 512, r = task & 255, c = task >> 8; vt_store(lds, vv[it], true, r, c); }
    if (tid < 128) { const unsigned z = opaque_zero(); *(LAS u32x4*)(lds + LDS_VT + (tid >> 1) * VT_STRIDE + 512 + 16 * (tid & 1)) = (u32x4){z, z, z, z}; }
    bf16x8 q0[2], q1[2];
#pragma unroll
    for (int g2 = 0; g2 < 2; ++g2) { u32x4 w1, w2; row_finish<false>(qt[g2], true, gq, rf0, QSCALE, 16, 32, w1, w2); q0[g2] = __builtin_bit_cast(bf16x8, w1); q1[g2] = __builtin_bit_cast(bf16x8, w2); }
    __syncthreads();
    {
        const long tok = (long)b * SEQ + (long)blk * 256 + 16 * wave + fr;
        bf16_t* const orow[2] = {Y + tok * DM + YC_MEM + h * 64, Y + (tok + 128) * DM + YC_MEM + h * 64};
        const float nosink[2] = {0.f, 0.f};
        attn_multi<16, false, 2>(lds, q0, q1, 0, 0, false, nosink, orow, fr, fq);
    }
    __syncthreads();
}
typedef __bf16 v2bf16 __attribute__((ext_vector_type(2)));
constexpr int LDS_CG = 0, LDS_CW = 94 * 768, LDS_CPART = LDS_CW + 16 * CONVC * 4, LDS_CSTAT = LDS_CPART + 48 * 65 * 8;
static_assert(LDS_CSTAT + 512 <= 131072, "conv LDS map");
__device__ __forceinline__ float dot2bf(unsigned a, unsigned b, float c) { return __builtin_amdgcn_fdot2_f32_bf16(__builtin_bit_cast(v2bf16, a), __builtin_bit_cast(v2bf16, b), c, false); }
__device__ __forceinline__ void conv_unit(LAS unsigned char* lds, int l, int unit) {
    const KP pp = kparams(); struct { unsigned char* ws; const float* conv_w; const float* conv_b; const float* conv_ln_g; const float* conv_ln_b; } p = {pp->ws, pp->conv_w, pp->conv_b, pp->conv_ln_g, pp->conv_ln_b};
    const int tid = opaque_tid();
    const int tb = unit & 127, b = unit >> 7, t0 = tb * 64;
    const bf16_t* P = (const bf16_t*)(p.ws + WS_P); bf16_t* Y = (bf16_t*)(p.ws + WS_Y);
    const float* cw = p.conv_w + (size_t)l * CONVW * CONVC; const float* cb = p.conv_b + l * CONVC;
    const float* lg = p.conv_ln_g + l * CONVC; const float* lb = p.conv_ln_b + l * CONVC;
    {
        bf16x8 av[9], gv[9]; float w0[12], w1[12];
#pragma unroll
        for (int it = 0; it < 12; ++it) { const int idx = tid + it * 512, jp = idx / CONVC, c = idx - jp * CONVC;
            w0[it] = cw[(2 * jp) * CONVC + c]; w1[it] = (2 * jp + 1 < CONVW) ? cw[(2 * jp + 1) * CONVC + c] : 0.f; }
        const unsigned z = opaque_zero(); const bf16x8 zv = __builtin_bit_cast(bf16x8, (u32x4){z, z, z, z});
#pragma unroll
        for (int it = 0; it < 9; ++it) {
            const int task = tid + it * 512, row = task / 48, ch = task - row * 48, t = t0 - 30 + row;
            av[it] = zv; gv[it] = zv;
            if (task < 94 * 48 && t >= 0) { const bf16_t* pr = P + ((long)b * SEQ + t) * DINP + 8 * ch; av[it] = *(const bf16x8*)(pr + PC_A); gv[it] = *(const bf16x8*)(pr + PC_G); }
        }
#pragma unroll
        for (int it = 0; it < 12; ++it) *(LAS unsigned*)(lds + LDS_CW + 4 * (tid + it * 512)) = cvt_pk_bf16(w0[it], w1[it]);
#pragma unroll
        for (int it = 0; it < 9; ++it) {
            const int task = tid + it * 512, row = task / 48, ch = task - row * 48;
            float y[8];
#pragma unroll
            for (int e = 0; e < 8; ++e) y[e] = bf2f(av[it][e]) * sigmoid_f(bf2f(gv[it][e]));
            u32x4 o; o.x = cvt_pk_bf16(y[0], y[1]); o.y = cvt_pk_bf16(y[2], y[3]); o.z = cvt_pk_bf16(y[4], y[5]); o.w = cvt_pk_bf16(y[6], y[7]);
            if (task < 94 * 48) *(LAS u32x4*)(lds + LDS_CG + row * 768 + 16 * ch) = o;
        }
    }
    __syncthreads();
    const int oct = tid % 48, grp = tid / 48;
    float acc[8][8];
    if (tid < 384) {
        const f32x4 b0 = *(const f32x4*)(cb + 8 * oct), b1 = *(const f32x4*)(cb + 8 * oct + 4);
#pragma unroll
        for (int tt = 0; tt < 8; ++tt)
#pragma unroll
            for (int e = 0; e < 4; ++e) { acc[tt][e] = b0[e]; acc[tt][4 + e] = b1[e]; }
#pragma unroll 1
        for (int jp = 0; jp < 16; ++jp) {
            const u32x4 wa = *(const LAS u32x4*)(lds + LDS_CW + (jp * CONVC + 8 * oct) * 4), wb = *(const LAS u32x4*)(lds + LDS_CW + (jp * CONVC + 8 * oct) * 4 + 16);
            u32x4 gr[9];
#pragma unroll
            for (int i = 0; i < 9; ++i) gr[i] = *(const LAS u32x4*)(lds + LDS_CG + (grp * 8 + 2 * jp + i) * 768 + 16 * oct);
#pragma unroll
            for (int tt = 0; tt < 8; ++tt) {
#pragma unroll
                for (int k = 0; k < 4; ++k) {
                    const unsigned lo = __builtin_amdgcn_perm(gr[tt + 1][k], gr[tt][k], 0x05040100u), hi = __builtin_amdgcn_perm(gr[tt + 1][k], gr[tt][k], 0x07060302u);
                    const unsigned wl = k < 2 ? wa[2 * k] : wb[2 * k - 4], wh = k < 2 ? wa[2 * k + 1] : wb[2 * k - 3];
                    acc[tt][2 * k] = dot2bf(lo, wl, acc[tt][2 * k]); acc[tt][2 * k + 1] = dot2bf(hi, wh, acc[tt][2 * k + 1]);
                }
            }
        }
#pragma unroll
        for (int tt = 0; tt < 8; ++tt) {
            float s = 0.f, q = 0.f;
#pragma unroll
            for (int e = 0; e < 8; ++e) { s += acc[tt][e]; q += acc[tt][e] * acc[tt][e]; }
            *(LAS f32x2*)(lds + LDS_CPART + (oct * 65 + grp * 8 + tt) * 8) = (f32x2){s, q};
        }
    }
    __syncthreads();
    if (tid < 64) {
        float s = 0.f, q = 0.f;
#pragma unroll 8
        for (int i = 0; i < 48; ++i) { const f32x2 v = *(LAS f32x2*)(lds + LDS_CPART + (i * 65 + tid) * 8); s += v.x; q += v.y; }
        const float mean = s * (1.0f / CONVC), var = fmaxf(q * (1.0f / CONVC) - mean * mean, 0.f);
        *(LAS float*)(lds + LDS_CSTAT + tid * 8) = mean; *(LAS float*)(lds + LDS_CSTAT + tid * 8 + 4) = 1.0f / sqrtf(var + EPS);
    }
    __syncthreads();
    if (tid < 384) {
        const f32x4 g0 = *(const f32x4*)(lg + 8 * oct), g1 = *(const f32x4*)(lg + 8 * oct + 4), b0 = *(const f32x4*)(lb + 8 * oct), b1 = *(const f32x4*)(lb + 8 * oct + 4);
#pragma unroll
        for (int tt = 0; tt < 8; ++tt) {
            const float mean = *(LAS float*)(lds + LDS_CSTAT + (grp * 8 + tt) * 8), rstd = *(LAS float*)(lds + LDS_CSTAT + (grp * 8 + tt) * 8 + 4);
            float y[8];
#pragma unroll
            for (int e = 0; e < 4; ++e) { y[e] = silu_f((acc[tt][e] - mean) * rstd * g0[e] + b0[e]); y[4 + e] = silu_f((acc[tt][4 + e] - mean) * rstd * g1[e] + b1[e]); }
            u32x4 w; w.x = cvt_pk_bf16(y[0], y[1]); w.y = cvt_pk_bf16(y[2], y[3]); w.z = cvt_pk_bf16(y[4], y[5]); w.w = cvt_pk_bf16(y[6], y[7]);
            store16_wt(Y + ((long)b * SEQ + t0 + grp * 8 + tt) * DM + YC_CONV + 8 * oct, w);
        }
    }
    __syncthreads();
}

__device__ __forceinline__ void phase_up(LAS unsigned char* lds, int l, int half) {
    const KP p = kparams(); unsigned char* ws = p->ws; const int G = gridDim.x, bid = opaque_bid();
    unsigned char* wl = ws + WS_W + (size_t)l * SZ_LAYER;
    pg8::Gemm g{(const bf16_t*)(ws + WS_RB), (const bf16_t*)(wl + (half ? OFF_W13B : OFF_W13A)), M, 2 * DFF, DM};
    pg8::PanelOrder S; S.init(2 * DFF, bid);
    pg8::EpiSwiglu E{(bf16_t*)(ws + WS_FF), pg8::RowScaleSpec{(const float*)(ws + WS_PA), (const float*)(ws + (half ? WS_PC : WS_PB)), (half == 0 && l > 0) ? 1 : 0, 1}};
    pg8::gemm_phase<pg8::EpiSwiglu, pg8::PanelOrder, true>(lds, g, S, E);
}
__device__ __forceinline__ void phase_memkv(LAS unsigned char* lds) {
    const KP p = kparams(); unsigned char* ws = p->ws; const int G = gridDim.x, bid = opaque_bid();
    if (bid < G - 16) return;
    pg8::Gemm gm{(const bf16_t*)(ws + WS_MEMB), (const bf16_t*)(ws + WS_WM), MROWS, 2048, DM};
    pg8::StaticOrder Sm; Sm.init(MROWS, 2048, 16, bid - (G - 16));
    pg8::EpiProj Em{(bf16_t*)(ws + WS_MKV), 2048, pg8::RowScaleSpec{(const float*)(ws + WS_PM), nullptr, 1, 0}};
    pg8::gemm_phase<pg8::EpiProj, pg8::StaticOrder, true>(lds, gm, Sm, Em);
}
__device__ __forceinline__ void phase_resid(LAS unsigned char* lds, int l, int kind) {
    const KP p = kparams(); unsigned char* ws = p->ws; const int G = gridDim.x, bid = opaque_bid();
    unsigned char* wl = ws + WS_W + (size_t)l * SZ_LAYER;
    bf16_t* RB = (bf16_t*)(ws + WS_RB);
    float* PA = (float*)(ws + WS_PA); float* PB = (float*)(ws + WS_PB); float* PC = (float*)(ws + WS_PC);
    pg8::Gemm g; pg8::EpiResid E;
    if (kind == 0) { g = pg8::Gemm{(const bf16_t*)(ws + WS_FF), (const bf16_t*)(wl + OFF_W2A), M, DM, DFF}; E = pg8::EpiResid{RB, pg8::RowScaleSpec{PA, nullptr, l == 0 ? 0 : 1, 0}, 0.5f, nullptr, PC, nullptr}; }
    else if (kind == 1) { g = pg8::Gemm{(const bf16_t*)(ws + WS_FF), (const bf16_t*)(wl + OFF_W2B), M, DM, DFF}; E = pg8::EpiResid{RB, pg8::RowScaleSpec{PA, nullptr, 0, 0}, 0.5f, p->final_norm + l * DM, PA, PB}; }
    else { g = pg8::Gemm{(const bf16_t*)(ws + WS_Y), (const bf16_t*)(wl + OFF_WOUT), M, DM, DM}; E = pg8::EpiResid{RB, pg8::RowScaleSpec{PA, nullptr, 0, 0}, 1.0f, nullptr, PC, nullptr}; }
    pg8::PanelOrder S; S.init(DM, bid);
    pg8::gemm_phase<pg8::EpiResid, pg8::PanelOrder, true>(lds, g, S, E);
}
__device__ __forceinline__ void phase_resid_final(LAS unsigned char* lds, int l) {
    const KP p = kparams(); unsigned char* ws = p->ws; const int bid = opaque_bid();
    unsigned char* wl = ws + WS_W + (size_t)l * SZ_LAYER;
    pg8::Gemm g{(const bf16_t*)(ws + WS_FF), (const bf16_t*)(wl + OFF_W2B), M, DM, DFF};
    pg8::EpiFinal E{(const bf16_t*)(ws + WS_RB), pg8::RowScaleSpec{nullptr, nullptr, 0, 0}, 0.5f, p->final_norm + l * DM, p->out, (float*)(ws + WS_XBUF), (unsigned*)(ws + WS_CTL) + CW_PANEL};
    pg8::PanelOrder S; S.init(DM, bid);
    pg8::gemm_phase<pg8::EpiFinal, pg8::PanelOrder, true>(lds, g, S, E);
}
__device__ __forceinline__ void phase_win(LAS unsigned char* lds, int l) {
    const KP p = kparams(); unsigned char* ws = p->ws; const int G = gridDim.x, bid = opaque_bid();
    unsigned char* wl = ws + WS_W + (size_t)l * SZ_LAYER;
    pg8::Gemm g{(const bf16_t*)(ws + WS_RB), (const bf16_t*)(wl + OFF_WIN), M, DINP, DM};
    pg8::PanelOrder S; S.init(DINP, bid);
    pg8::EpiProj E{(bf16_t*)(ws + WS_P), DINP, pg8::RowScaleSpec{(const float*)(ws + WS_PC), nullptr, 1, 0}};
    pg8::gemm_phase<pg8::EpiProj, pg8::PanelOrder, true>(lds, g, S, E);
}
__device__ __forceinline__ void phase_final() {
    const KP p = kparams(); unsigned char* ws = p->ws; const int G = gridDim.x, bid = opaque_bid();
    const float* PA = (const float*)(ws + WS_PA); float* R = p->out; const bf16_t* RB = (const bf16_t*)(ws + WS_RB);
    const int tid = opaque_tid(), lane = tid & 63, wave = tid >> 6, gw = bid * 8 + wave, NGW = G * 8;
    for (int m = gw; m < M; m += NGW) {
        float s = lane < 16 ? PA[(size_t)m * 16 + lane] : 0.f; s = wave_sum(s);
        const float r3 = 1.0f / sqrtf(s * (1.0f / DM) + EPS);
#pragma unroll
        for (int j = 0; j < 2; ++j) {
            const bf16x8 v = *(const bf16x8*)(RB + (size_t)m * DM + 512 * j + 8 * lane);
            f32x4* o = (f32x4*)(R + (size_t)m * DM + 512 * j + 8 * lane);
            o[0] = (f32x4){bf2f(v[0]) * r3, bf2f(v[1]) * r3, bf2f(v[2]) * r3, bf2f(v[3]) * r3};
            o[1] = (f32x4){bf2f(v[4]) * r3, bf2f(v[5]) * r3, bf2f(v[6]) * r3, bf2f(v[7]) * r3};
        }
    }
}

__global__ void __launch_bounds__(512, 2) fwd_megakernel(Params p_unused) {
    extern __shared__ __attribute__((aligned(16))) unsigned char lds_raw[];
    LAS unsigned char* lds = (LAS unsigned char*)lds_raw;
    cg::grid_group grid = cg::this_grid();
    if (threadIdx.x < 2) ((LAS unsigned*)(lds + LDS_MISC))[threadIdx.x] = 0u;
    if (threadIdx.x == 0) (void)xb_add((unsigned*)(kparams()->ws + WS_CTL) + XB_XCNT(xb_xcc_id()), 1u);
    __syncthreads();

    prologue(lds);
    if (gridDim.x == 0x7fffffffu) grid.sync();
    xcd_barrier(lds);
#pragma unroll 1
    for (int l = 0; l < DEPTH; ++l) {
        phase_up(lds, l, 0);
        if (l == 0) phase_memkv(lds);
        convert_in_tail(l + 1, 2, 0, 6, l == 0 ? 2 : 0);
        xcd_barrier(lds);
        phase_resid(lds, l, 0);
        xcd_barrier(lds);
        phase_win(lds, l);
        convert_in_tail(l + 1, 3, 6, 9);
        xcd_barrier(lds);
#pragma unroll 1
        for (int it = blockIdx.x; it < 768; it += gridDim.x) {
            if (it < 256) swa_unit(lds, l, it);
            else if (it < 512) conv_unit(lds, l, it - 256);
            else mem_unit(lds, l, it - 512);
        }
        xcd_barrier(lds);
        phase_resid(lds, l, 2);
        xcd_barrier(lds);
        phase_up(lds, l, 1);
        convert_in_tail(l + 1, 2, 9, 16);
        xcd_barrier(lds);
        if (l < DEPTH - 1) { phase_resid(lds, l, 1); xcd_barrier(lds); }
        else phase_resid_final(lds, l);
    }
}

extern "C" void kernel_launch(void* const* d_in, const int* in_sizes, int n_in, void* d_out, int out_size, void* d_ws, size_t ws_size, hipStream_t stream) {
    static int grid = 0;
    if (grid == 0) {
        if (n_in != 26 || in_sizes[0] != M * DM || out_size != M * DM || ws_size < WS_END) { fprintf(stderr, "kernel_launch: unexpected shapes (n_in %d in0 %d out %d ws %zu)\n", n_in, n_in > 0 ? in_sizes[0] : -1, out_size, ws_size); grid = -1; return; }
        int dev = 0, cus = 0, per_cu = 0;
        hipGetDevice(&dev);
        hipDeviceGetAttribute(&cus, hipDeviceAttributeMultiprocessorCount, dev);
        hipFuncSetAttribute((const void*)fwd_megakernel, hipFuncAttributeMaxDynamicSharedMemorySize, LDS_BYTES);
        hipOccupancyMaxActiveBlocksPerMultiprocessor(&per_cu, (const void*)fwd_megakernel, 512, LDS_BYTES);
        (void)hipGetLastError();
        if (per_cu < 1) fprintf(stderr, "kernel_launch: occupancy query says %d blocks per CU\n", per_cu);
        grid = cus;
        if (grid != 256) { fprintf(stderr, "kernel_launch: this kernel's tile assignment is built for 256 CUs, found %d; launching 256 workgroups anyway\n", cus); grid = 256; }
    }
    if (grid < 0) return;
    Params p{};
    p.x = (const float*)d_in[0]; p.mem = (const float*)d_in[1]; p.pos = (const int*)d_in[2];
    p.ffn1_norm = (const float*)d_in[3]; p.ffn1_w1 = (const float*)d_in[4]; p.ffn1_w3 = (const float*)d_in[5]; p.ffn1_w2 = (const float*)d_in[6];
    p.mix_norm = (const float*)d_in[7]; p.w_in = (const float*)d_in[8]; p.conv_w = (const float*)d_in[9]; p.conv_b = (const float*)d_in[10];
    p.conv_ln_g = (const float*)d_in[11]; p.conv_ln_b = (const float*)d_in[12]; p.swa_q_norm = (const float*)d_in[13]; p.swa_k_norm = (const float*)d_in[14];
    p.swa_sinks = (const float*)d_in[15]; p.mem_norm = (const float*)d_in[16]; p.w_mem_kv = (const float*)d_in[17]; p.mem_q_norm = (const float*)d_in[18];
    p.mem_k_norm = (const float*)d_in[19]; p.w_out = (const float*)d_in[20]; p.ffn2_norm = (const float*)d_in[21]; p.ffn2_w1 = (const float*)d_in[22];
    p.ffn2_w3 = (const float*)d_in[23]; p.ffn2_w2 = (const float*)d_in[24]; p.final_norm = (const float*)d_in[25];
    p.out = (float*)d_out; p.ws = (unsigned char*)d_ws;
    if (hipMemsetAsync((char*)d_ws + WS_CTL, 0, CTL_ZERO_BYTES, stream) != hipSuccess) { fprintf(stderr, "kernel_launch: memset failed\n"); return; }
    void* args[] = {&p};
    hipError_t e = hipLaunchCooperativeKernel((const void*)fwd_megakernel, dim3(grid), dim3(512), args, LDS_BYTES, stream);
    if (e != hipSuccess) fprintf(stderr, "kernel_launch: cooperative launch failed: %s (grid %d)\n", hipGetErrorString(e), grid);
}
```

```cpp
#include <hip/hip_runtime.h>
#include <hip/hip_cooperative_groups.h>
#include <cstdio>
#include <cstdint>
namespace cg = cooperative_groups;

#define LAS __attribute__((address_space(3)))
typedef unsigned short bf16_t;
typedef short bf16x8 __attribute__((ext_vector_type(8)));
typedef short s16x4 __attribute__((ext_vector_type(4)));
typedef float f32x4 __attribute__((ext_vector_type(4)));
typedef unsigned u32x4 __attribute__((ext_vector_type(4)));
typedef unsigned u32x2 __attribute__((ext_vector_type(2)));
typedef float f32x2 __attribute__((ext_vector_type(2)));

constexpr int DM = 1024, BATCH = 2, SEQ = 8192, DEPTH = 4, MEMLEN = 256, HD = 64;
constexpr int M = BATCH * SEQ;
constexpr int CONVC = 384, CONVW = 31;
constexpr int DIN = 1664, DINP = 1792;
constexpr int DFF = 2816;
constexpr int MROWS = BATCH * MEMLEN;
constexpr float EPS = 1e-6f;
constexpr int PC_A = 0, PC_G = 384, PC_Q = 768, PC_K = 1152, PC_V = 1280, PC_QM = 1408;
constexpr int YC_CONV = 0, YC_SWA = 384, YC_MEM = 768;

constexpr size_t MiB = 1u << 20;
constexpr size_t WS_PA = 0 * MiB, WS_PB = 1 * MiB, WS_PC = 2 * MiB;
constexpr size_t WS_XBUF = 3 * MiB + 256 * 1024;
constexpr int CW_PANEL = 8192;
constexpr size_t WS_PM = 3 * MiB;
constexpr size_t WS_COS = 4 * MiB, WS_SIN = 6 * MiB;
constexpr size_t WS_MEMB = 8 * MiB;
constexpr size_t WS_MKV = 9 * MiB;
constexpr size_t WS_CTL = 12 * MiB, CTL_ZERO_BYTES = 65536;
constexpr size_t WS_W = 16 * MiB;
constexpr size_t SZ_W13 = (size_t)2 * DFF * DM * 2, SZ_W2 = (size_t)DM * DFF * 2, SZ_WIN = (size_t)DINP * DM * 2, SZ_WOUT = (size_t)DM * DM * 2;
constexpr size_t OFF_W13A = 0, OFF_W2A = OFF_W13A + SZ_W13, OFF_WIN = OFF_W2A + SZ_W2, OFF_WOUT = OFF_WIN + SZ_WIN, OFF_W13B = OFF_WOUT + SZ_WOUT, OFF_W2B = OFF_W13B + SZ_W13;
constexpr size_t SZ_LAYER = OFF_W2B + SZ_W2;
constexpr size_t WS_WM = WS_W + 4 * SZ_LAYER;
constexpr size_t WS_RB = 176 * MiB;
constexpr size_t WS_FF = 208 * MiB;
constexpr size_t WS_P = WS_FF, WS_Y = WS_FF + 56 * MiB;
constexpr size_t WS_END = 296 * MiB;
static_assert(WS_WM + (size_t)2048 * 1024 * 2 <= WS_RB, "ws map");
static_assert(SZ_LAYER == (size_t)77 * MiB / 2, "layer weights 38.5 MiB");

constexpr int LDS_BYTES = 147456;
constexpr int LDS_RS_OFF = 131072 + 64;
constexpr int LDS_MISC = 131072;

__device__ __forceinline__ unsigned cvt_pk_bf16(float lo, float hi) { unsigned r; asm volatile("v_cvt_pk_bf16_f32 %0, %1, %2" : "=v"(r) : "v"(lo), "v"(hi)); return r; }
__device__ __forceinline__ float bf2f(short s) { return __uint_as_float(((unsigned)(unsigned short)s) << 16); }
__device__ __forceinline__ float wave_sum(float v) {
#pragma unroll
    for (int o = 1; o < 64; o <<= 1) v += __shfl_xor(v, o);
    return v;
}
__device__ __forceinline__ float fast_rcp(float x) { return __builtin_amdgcn_rcpf(x); }
__device__ __forceinline__ float silu_f(float x) { return x * fast_rcp(1.0f + __builtin_amdgcn_exp2f(-1.4426950408889634f * x)); }
__device__ __forceinline__ float sigmoid_f(float x) { return fast_rcp(1.0f + __builtin_amdgcn_exp2f(-1.4426950408889634f * x)); }

__device__ __forceinline__ void store16_wt(void* p, u32x4 v) { asm volatile("global_store_dwordx4 %0, %1, off sc1\n\ts_nop 1" :: "v"(p), "v"(v) : "memory"); }
__device__ __forceinline__ void store8_wt(void* p, u32x2 v) { asm volatile("global_store_dwordx2 %0, %1, off sc1\n\ts_nop 1" :: "v"(p), "v"(v) : "memory"); }
__device__ __forceinline__ int opaque_tid() { int t = threadIdx.x; asm volatile("" : "+v"(t)); return t; }
__device__ __forceinline__ unsigned opaque_zero() { unsigned z = 0u; asm volatile("" : "+v"(z)); return z; }
__device__ __forceinline__ int opaque_bid() { int t = blockIdx.x; asm volatile("" : "+s"(t)); return t; }
template <class T> __device__ __forceinline__ T* opaque_ptr(T* q) { asm volatile("" : "+s"(q)); return q; }

__device__ __forceinline__ unsigned xb_ld(unsigned* p);
__device__ __forceinline__ unsigned xb_add(unsigned* p, unsigned v);
#ifndef PG8_SP2_DEFAULT
#define PG8_SP2_DEFAULT true
#endif
namespace pg8 {
constexpr int BM = 256, BK = 64, HALF = 128, HTB = HALF * BK * 2, STAGE_BYTES = 8 * HTB, NXCD = 8, WGM = 8;
__host__ __device__ __forceinline__ int lds_byte(int r, int c) { const int st = (r >> 4) * 2 + (c >> 5), rr = r & 15, cc = c & 31, ob = rr * 64 + cc * 2; return st * 1024 + (ob ^ (((ob >> 9) & 1) << 5)); }
__host__ __device__ __forceinline__ void stage_rc(int b, int& R, int& C) { const int st = b / 1024, sb = b % 1024, swz = sb ^ (((sb >> 9) & 1) << 5); R = (st >> 1) * 16 + swz / 64; C = (st & 1) * 32 + (swz % 64) / 2; }
__host__ __device__ __forceinline__ int perm32(int rho) { const int n = rho >> 4, i = rho & 15; return 8 * (i >> 2) + 4 * n + (i & 3); }

struct Unit { int pm, pn; };
struct Gemm { const bf16_t* A; const bf16_t* Bt; int M, N, K; };

struct StaticOrder {
    int nM, nN, nwg, G, c;
    __device__ void init(int M_, int N_, int G_, int c_) { nM = M_ / BM; nN = N_ / BM; nwg = nM * nN; G = G_; c = c_; }
    __device__ bool next(int i, Unit& u) const {
        const long L = (long)i * G + c; if (L >= nwg) return false;
        int wgid = (int)L; { const int q = nwg / NXCD, r = nwg % NXCD, xcd = wgid % NXCD, off = wgid / NXCD; wgid = (xcd < r ? xcd * (q + 1) : r * (q + 1) + (xcd - r) * q) + off; }
        const int nig = WGM * nN, gid = wgid / nig, fm = gid * WGM, gsz = (nM - fm) < WGM ? (nM - fm) : WGM;
        u.pm = fm + ((wgid % nig) % gsz); u.pn = (wgid % nig) / gsz; return true;
    }
};

struct PanelOrder {
    int nN, pm, k;
    __device__ void init(int N_, int c_) { nN = N_ / BM; const int j = c_ >> 3; pm = 8 * (c_ & 7) + (j & 7); k = j >> 3; }
    __device__ bool next(int i, Unit& u) const { const int pn = k + 4 * i; if (pn >= nN) return false; u.pm = pm; u.pn = pn; return true; }
};


struct RowScaleSpec { const float* PA; const float* PB; int useA, withB; };
__device__ __forceinline__ void read_row_scales(LAS const float* rst, int wr, int fr, float (&rs)[2][4]) {
#pragma unroll
    for (int ai = 0; ai < 2; ++ai)
#pragma unroll
        for (int m = 0; m < 4; ++m) rs[ai][m] = rst[ai * HALF + wr * 64 + m * 16 + fr];
}

struct EpiSwiglu {
    static constexpr bool PERM = true;
    bf16_t* O; RowScaleSpec rsp;
    __device__ __forceinline__ void operator()(const f32x4 (&acc)[2][2][4][2], const Unit& u, int wr, int wc, int fr, int fq, LAS const float* rst) const {
        asm volatile("" : "+v"(fr), "+v"(fq));
        const int row0 = u.pm * BM + wr * 64 + fr, col0 = u.pn * HALF + wc * 32 + 8 * fq;
        float rs[2][4];
        read_row_scales(rst, wr, fr, rs);
#pragma unroll
        for (int ai = 0; ai < 2; ++ai)
#pragma unroll
            for (int m = 0; m < 4; ++m) {
                const float r = rs[ai][m], nr = -1.4426950408889634f * r, r2 = r * r;
                float o[8];
#pragma unroll
                for (int n = 0; n < 2; ++n)
#pragma unroll
                    for (int jp = 0; jp < 2; ++jp) {
                        const f32x2 a = {acc[ai][0][m][n][2 * jp], acc[ai][0][m][n][2 * jp + 1]}, b = {acc[ai][1][m][n][2 * jp], acc[ai][1][m][n][2 * jp + 1]};
                        const f32x2 t = a * nr; f32x2 e; e.x = __builtin_amdgcn_exp2f(t.x); e.y = __builtin_amdgcn_exp2f(t.y);
                        const f32x2 d = e + 1.0f; f32x2 q; q.x = __builtin_amdgcn_rcpf(d.x); q.y = __builtin_amdgcn_rcpf(d.y);
                        const f32x2 ov = (a * b) * (q * r2);
                        o[4 * n + 2 * jp] = ov.x; o[4 * n + 2 * jp + 1] = ov.y;
                    }
                u32x4 w; w.x = cvt_pk_bf16(o[0], o[1]); w.y = cvt_pk_bf16(o[2], o[3]); w.z = cvt_pk_bf16(o[4], o[5]); w.w = cvt_pk_bf16(o[6], o[7]);
                *(u32x4*)(O + (size_t)(row0 + ai * HALF + m * 16) * DFF + col0) = w;
            }
    }
};
struct EpiProj {
    static constexpr bool PERM = true;
    bf16_t* O; int ldc; RowScaleSpec rsp;
    __device__ __forceinline__ void operator()(const f32x4 (&acc)[2][2][4][2], const Unit& u, int wr, int wc, int fr, int fq, LAS const float* rst) const {
        asm volatile("" : "+v"(fr), "+v"(fq));
        const int row0 = u.pm * BM + wr * 64 + fr, col0 = u.pn * BM + wc * 32 + 8 * fq;
        float rs[2][4];
        read_row_scales(rst, wr, fr, rs);
#pragma unroll
        for (int ai = 0; ai < 2; ++ai)
#pragma unroll
            for (int m = 0; m < 4; ++m) {
                const float r = rs[ai][m];
#pragma unroll
                for (int bj = 0; bj < 2; ++bj) {
                    const f32x4 v0 = acc[ai][bj][m][0] * r, v1 = acc[ai][bj][m][1] * r;
                    u32x4 w; w.x = cvt_pk_bf16(v0[0], v0[1]); w.y = cvt_pk_bf16(v0[2], v0[3]); w.z = cvt_pk_bf16(v1[0], v1[1]); w.w = cvt_pk_bf16(v1[2], v1[3]);
                    store16_wt(O + (size_t)(row0 + ai * HALF + m * 16) * ldc + col0 + bj * HALF, w);
                }
            }
    }
};
struct EpiResid {
    static constexpr bool PERM = true;
    bf16_t* ob; RowScaleSpec rsp; float alpha; const float* gf; float* P1; float* P2;
    __device__ __forceinline__ void operator()(const f32x4 (&acc)[2][2][4][2], const Unit& u, int wr, int wc, int fr, int fq, LAS const float* rst) const {
        asm volatile("" : "+v"(fr), "+v"(fq));
        const int row0 = u.pm * BM + wr * 64 + fr, col0 = u.pn * BM + wc * 32 + 8 * fq;
        float r3[2][4];
        read_row_scales(rst, wr, fr, r3);
        f32x4 g[2][2];
#pragma unroll
        for (int bj = 0; bj < 2; ++bj)
#pragma unroll
            for (int n = 0; n < 2; ++n) g[bj][n] = gf ? *(const f32x4*)(gf + col0 + bj * HALF + 4 * n) : (f32x4){1.f, 1.f, 1.f, 1.f};
#pragma unroll
        for (int ai = 0; ai < 2; ++ai) {
            bf16x8 rb[4][2];
#pragma unroll
            for (int m = 0; m < 4; ++m)
#pragma unroll
                for (int bj = 0; bj < 2; ++bj) rb[m][bj] = *(const bf16x8*)(ob + (size_t)(row0 + ai * HALF + m * 16) * DM + col0 + bj * HALF);
#pragma unroll
            for (int m = 0; m < 4; ++m) {
                const int row = row0 + ai * HALF + m * 16; const size_t off = (size_t)row * DM + col0;
                float s1 = 0.f, s2 = 0.f;
#pragma unroll
                for (int bj = 0; bj < 2; ++bj) {
                    const bf16x8 t = rb[m][bj];
                    const f32x4 i0 = (f32x4){bf2f(t[0]), bf2f(t[1]), bf2f(t[2]), bf2f(t[3])}, i1 = (f32x4){bf2f(t[4]), bf2f(t[5]), bf2f(t[6]), bf2f(t[7])};
                    const f32x4 h0 = i0 * r3[ai][m] + acc[ai][bj][m][0] * alpha, h1 = i1 * r3[ai][m] + acc[ai][bj][m][1] * alpha;
                    s1 += (h0[0] * h0[0] + h0[1] * h0[1]) + (h0[2] * h0[2] + h0[3] * h0[3]) + (h1[0] * h1[0] + h1[1] * h1[1]) + (h1[2] * h1[2] + h1[3] * h1[3]);
                    const f32x4 z0 = h0 * g[bj][0], z1 = h1 * g[bj][1];
                    s2 += (z0[0] * z0[0] + z0[1] * z0[1]) + (z0[2] * z0[2] + z0[3] * z0[3]) + (z1[0] * z1[0] + z1[1] * z1[1]) + (z1[2] * z1[2] + z1[3] * z1[3]);
                    u32x4 w; w.x = cvt_pk_bf16(z0[0], z0[1]); w.y = cvt_pk_bf16(z0[2], z0[3]); w.z = cvt_pk_bf16(z1[0], z1[1]); w.w = cvt_pk_bf16(z1[2], z1[3]);
                    *(u32x4*)(ob + off + bj * HALF) = w;
                }
                s1 += __shfl_xor(s1, 16); s1 += __shfl_xor(s1, 32);
                s2 += __shfl_xor(s2, 16); s2 += __shfl_xor(s2, 32);
                if (fq == 0) { P1[(size_t)row * 16 + u.pn * 4 + wc] = s1; if (P2) P2[(size_t)row * 16 + u.pn * 4 + wc] = s2; }
            }
        }
    }
};

struct EpiFinal {
    static constexpr bool PERM = true;
    const bf16_t* rbuf; RowScaleSpec rsp; float alpha; const float* gf; float* out; float* xbuf; unsigned* cnt;
    __device__ __forceinline__ void operator()(f32x4 (&acc)[2][2][4][2], const Unit& u, int wr, int wc, int fr, int fq, LAS const float* rst) const {
        asm volatile("" : "+v"(fr), "+v"(fq));
        LAS float* tab = (LAS float*)((LAS unsigned char*)rst + 1024);
        LAS float* r3t = (LAS float*)((LAS unsigned char*)rst + 1024 + 4096);
        const int tid = opaque_tid();
        const int row0 = u.pm * BM + wr * 64 + fr, col0 = u.pn * BM + wc * 32 + 8 * fq;
        f32x4 g[2][2];
#pragma unroll
        for (int bj = 0; bj < 2; ++bj)
#pragma unroll
            for (int n = 0; n < 2; ++n) g[bj][n] = *(const f32x4*)(gf + col0 + bj * HALF + 4 * n);
#pragma unroll
        for (int ai = 0; ai < 2; ++ai) {
            bf16x8 rb[4][2];
#pragma unroll
            for (int m = 0; m < 4; ++m)
#pragma unroll
                for (int bj = 0; bj < 2; ++bj) rb[m][bj] = *(const bf16x8*)(rbuf + (size_t)(row0 + ai * HALF + m * 16) * DM + col0 + bj * HALF);
#pragma unroll
            for (int m = 0; m < 4; ++m) {
                float s1 = 0.f;
#pragma unroll
                for (int bj = 0; bj < 2; ++bj) {
                    const bf16x8 t = rb[m][bj];
                    const f32x4 i0 = (f32x4){bf2f(t[0]), bf2f(t[1]), bf2f(t[2]), bf2f(t[3])}, i1 = (f32x4){bf2f(t[4]), bf2f(t[5]), bf2f(t[6]), bf2f(t[7])};
                    const f32x4 h0 = i0 + acc[ai][bj][m][0] * alpha, h1 = i1 + acc[ai][bj][m][1] * alpha;
                    s1 += (h0[0] * h0[0] + h0[1] * h0[1]) + (h0[2] * h0[2] + h0[3] * h0[3]) + (h1[0] * h1[0] + h1[1] * h1[1]) + (h1[2] * h1[2] + h1[3] * h1[3]);
                    acc[ai][bj][m][0] = h0 * g[bj][0]; acc[ai][bj][m][1] = h1 * g[bj][1];
                }
                s1 += __shfl_xor(s1, 16); s1 += __shfl_xor(s1, 32);
                if (fq == 0) tab[(ai * HALF + wr * 64 + m * 16 + fr) * 4 + wc] = s1;
            }
        }
        asm volatile("s_waitcnt lgkmcnt(0)" ::: "memory"); __builtin_amdgcn_s_barrier(); asm volatile("" ::: "memory");
        if (tid < BM) {
            const float ts = (tab[tid * 4 + 0] + tab[tid * 4 + 1]) + (tab[tid * 4 + 2] + tab[tid * 4 + 3]);
            __hip_atomic_store(xbuf + (size_t)(u.pm * BM + tid) * 4 + u.pn, ts, __ATOMIC_RELAXED, __HIP_MEMORY_SCOPE_AGENT);
        }
        asm volatile("s_waitcnt vmcnt(0) lgkmcnt(0)" ::: "memory"); __builtin_amdgcn_s_barrier(); asm volatile("" ::: "memory");
        if (tid == 0) {
            unsigned* c = cnt + 64 * u.pm;
            (void)xb_add(c, 1u);
            unsigned sp = 0;
            while (xb_ld(c) < 4u) { __builtin_amdgcn_s_sleep(1); if (++sp > (1u << 22)) break; }
            __builtin_amdgcn_fence(__ATOMIC_ACQUIRE, "agent");
            asm volatile("s_waitcnt vmcnt(0)" ::: "memory");
        }
        asm volatile("s_waitcnt lgkmcnt(0)" ::: "memory"); __builtin_amdgcn_s_barrier(); asm volatile("" ::: "memory");
        if (tid < BM) {
            const float* xr = xbuf + (size_t)(u.pm * BM + tid) * 4;
            const float t0 = __hip_atomic_load(xr + 0, __ATOMIC_RELAXED, __HIP_MEMORY_SCOPE_AGENT), t1 = __hip_atomic_load(xr + 1, __ATOMIC_RELAXED, __HIP_MEMORY_SCOPE_AGENT);
            const float t2 = __hip_atomic_load(xr + 2, __ATOMIC_RELAXED, __HIP_MEMORY_SCOPE_AGENT), t3 = __hip_atomic_load(xr + 3, __ATOMIC_RELAXED, __HIP_MEMORY_SCOPE_AGENT);
            r3t[tid] = __builtin_amdgcn_rsqf(((t0 + t1) + (t2 + t3)) * (1.0f / DM) + EPS);
        }
        asm volatile("s_waitcnt vmcnt(0) lgkmcnt(0)" ::: "memory"); __builtin_amdgcn_s_barrier(); asm volatile("" ::: "memory");
#pragma unroll
        for (int ai = 0; ai < 2; ++ai)
#pragma unroll
            for (int m = 0; m < 4; ++m) {
                const float r3 = r3t[ai * HALF + wr * 64 + m * 16 + fr];
                float* orow = out + (size_t)(row0 + ai * HALF + m * 16) * DM + col0;
#pragma unroll
                for (int bj = 0; bj < 2; ++bj) { *(f32x4*)(orow + bj * HALF) = acc[ai][bj][m][0] * r3; *(f32x4*)(orow + bj * HALF + 4) = acc[ai][bj][m][1] * r3; }
            }
    }
};

template <class Epi, class Sched, bool ALIGN_EPI, bool SP2 = PG8_SP2_DEFAULT>
__device__ __forceinline__ void gemm_phase(LAS unsigned char* lds, const Gemm g, const Sched& S, const Epi& E) {
    const int tid = opaque_tid(), wid = __builtin_amdgcn_readfirstlane(tid >> 6), lane = tid & 63, wr = wid >> 2, wc = wid & 3, fr = lane & 15, fq = lane >> 4;
    const int K = g.K, nt = K / BK;
    unsigned voffA[2], voffB[2];
#pragma unroll
    for (int i = 0; i < 2; ++i) { int R, C; stage_rc(tid * 16 + i * 8192, R, C); const int Rb = Epi::PERM ? ((R & ~31) + perm32(R & 31)) : R;
        voffA[i] = (unsigned)(R * K + C) * 2u; voffB[i] = (unsigned)(Rb * K + C) * 2u; }
    const size_t kstep = (size_t)(BK * 2);
    const size_t hstep = (size_t)HALF * K * 2;
    const size_t tstep = 2 * hstep;
    const unsigned ldsw = (unsigned)wid * 1024u;
    const int aoff = lds_byte(wr * 64 + fr, fq * 8), boff = lds_byte(wc * 32 + fr, fq * 8);
#define PG8_SA(b, h) (((b) * 2 + (h)) * HTB)
#define PG8_SB(b, h) ((4 + (b) * 2 + (h)) * HTB)
#define PG8_STAGE(bufoff, gbase, voff) do { _Pragma("unroll") for (int _i = 0; _i < 2; ++_i) \
        __builtin_amdgcn_global_load_lds((const unsigned*)((const char*)(gbase) + (voff)[_i]), (LAS unsigned*)(lds + (bufoff) + ldsw + _i * 8192), 16, 0, 0); } while (0)
#define PG8_LDA(dst, b, h) do { _Pragma("unroll") for (int m = 0; m < 4; ++m) _Pragma("unroll") for (int k = 0; k < 2; ++k) dst[m][k] = *(const LAS bf16x8*)(lds + PG8_SA(b, h) + aoff + m * 2048 + k * 1024); } while (0)
#define PG8_LDB(dst, b, h) do { _Pragma("unroll") for (int n = 0; n < 2; ++n) _Pragma("unroll") for (int k = 0; k < 2; ++k) dst[n][k] = *(const LAS bf16x8*)(lds + PG8_SB(b, h) + boff + n * 2048 + k * 1024); } while (0)
#define PG8_MMA(ai, bj, At, Bt) do { __builtin_amdgcn_s_setprio(1); _Pragma("unroll") for (int m = 0; m < 4; ++m) _Pragma("unroll") for (int n = 0; n < 2; ++n) _Pragma("unroll") for (int k = 0; k < 2; ++k) \
        acc[ai][bj][m][n] = __builtin_amdgcn_mfma_f32_16x16x32_bf16(Bt[n][k], At[m][k], acc[ai][bj][m][n], 0, 0, 0); __builtin_amdgcn_s_setprio(0); } while (0)
#define PG8_WAIT_V(n) asm volatile("s_waitcnt vmcnt(" #n ")" ::: "memory")
#define PG8_WAIT_L(n) asm volatile("s_waitcnt lgkmcnt(" #n ")" ::: "memory")
#define PG8_BAR __builtin_amdgcn_s_barrier()
#define PG8_SCHED __builtin_amdgcn_sched_barrier(0)
    Unit cur, nxt; int ui = 0;
    if (!S.next(0, cur)) return;
    f32x4 acc[2][2][4][2];
#pragma unroll
    for (int a = 0; a < 2; ++a)
#pragma unroll
        for (int b = 0; b < 2; ++b)
#pragma unroll
            for (int m = 0; m < 4; ++m)
#pragma unroll
                for (int n = 0; n < 2; ++n) acc[a][b][m][n] = (f32x4){0.f, 0.f, 0.f, 0.f};
    bf16x8 At[4][2], B0[2][2], B1[2][2];
    const char* cA = (const char*)g.A + (size_t)cur.pm * tstep; const char* cB = (const char*)g.Bt + (size_t)cur.pn * tstep;
    LAS float* rst = (LAS float*)(lds + LDS_RS_OFF);
    const RowScaleSpec rsp = E.rsp; const bool rs_ld = (rsp.useA | rsp.withB) != 0;
    f32x4 pa0 = {0.f, 0.f, 0.f, 0.f}, pa1 = pa0, pb0 = pa0, pb1 = pa0;
    if (rs_ld) { const size_t o = (size_t)(cur.pm * BM + (tid >> 1)) * 16 + (tid & 1) * 8;
        pa0 = *(const f32x4*)(rsp.PA + o); pa1 = *(const f32x4*)(rsp.PA + o + 4);
        if (rsp.withB) { pb0 = *(const f32x4*)(rsp.PB + o); pb1 = *(const f32x4*)(rsp.PB + o + 4); } }
    if constexpr (SP2) { PG8_STAGE(PG8_SB(0, 0), cB, voffB); PG8_STAGE(PG8_SB(0, 1), cB + hstep, voffB); PG8_STAGE(PG8_SA(0, 0), cA, voffA); PG8_STAGE(PG8_SA(0, 1), cA + hstep, voffA); }
    else { PG8_STAGE(PG8_SB(0, 0), cB, voffB); PG8_STAGE(PG8_SA(0, 0), cA, voffA); PG8_STAGE(PG8_SB(0, 1), cB + hstep, voffB); PG8_STAGE(PG8_SA(0, 1), cA + hstep, voffA); }
    {
        float sa = ((pa0[0] + pa0[1]) + (pa0[2] + pa0[3])) + ((pa1[0] + pa1[1]) + (pa1[2] + pa1[3])); sa += __shfl_xor(sa, 1);
        float sb = ((pb0[0] + pb0[1]) + (pb0[2] + pb0[3])) + ((pb1[0] + pb1[1]) + (pb1[2] + pb1[3])); sb += __shfl_xor(sb, 1);
        float r = rsp.useA ? __builtin_amdgcn_rsqf(sa * (1.0f / DM) + EPS) : 1.0f;
        if (rsp.withB) r = r * __builtin_amdgcn_rsqf(r * r * sb * (1.0f / DM) + EPS);
        if ((tid & 1) == 0) rst[tid >> 1] = r;
    }
    if (wr == 1) PG8_BAR;
    if constexpr (SP2) { PG8_WAIT_V(2); } else { PG8_WAIT_V(4); } PG8_BAR;
    PG8_STAGE(PG8_SB(1, 0), cB + kstep, voffB); PG8_STAGE(PG8_SA(1, 0), cA + kstep, voffA); PG8_STAGE(PG8_SB(1, 1), cB + hstep + kstep, voffB);
    PG8_WAIT_V(6); PG8_BAR;
    for (;;) {
        const bool has_next = S.next(ui + 1, nxt);
        const char* nA = has_next ? (const char*)g.A + (size_t)nxt.pm * tstep : cA; const char* nB = has_next ? (const char*)g.Bt + (size_t)nxt.pn * tstep : cB;
        for (int t = 0; t < nt; t += 2) {
            const bool last = (t == nt - 2);
            const char* a1 = cA + (size_t)(t + 1) * kstep;
            const char* a2 = last ? nA : cA + (size_t)(t + 2) * kstep; const char* b2 = last ? nB : cB + (size_t)(t + 2) * kstep;
            const char* a3 = a2 + kstep; const char* b3 = b2 + kstep;
            if constexpr (SP2) {
            PG8_LDB(B0, 0, 0); PG8_LDB(B1, 0, 1); PG8_SCHED; PG8_LDA(At, 0, 0); PG8_STAGE(PG8_SA(1, 1), a1 + hstep, voffA);
            PG8_WAIT_V(8); PG8_WAIT_L(0); PG8_BAR; PG8_MMA(0, 0, At, B0); PG8_MMA(0, 1, At, B1); PG8_BAR; PG8_SCHED;
            PG8_LDA(At, 0, 1); PG8_STAGE(PG8_SB(0, 0), b2, voffB); PG8_STAGE(PG8_SB(0, 1), b2 + hstep, voffB); PG8_STAGE(PG8_SA(0, 0), a2, voffA);
            PG8_WAIT_V(8); PG8_WAIT_L(0); PG8_BAR; PG8_MMA(1, 0, At, B0); PG8_MMA(1, 1, At, B1); PG8_BAR; PG8_SCHED;
            PG8_LDB(B0, 1, 0); PG8_LDB(B1, 1, 1); PG8_SCHED; PG8_LDA(At, 1, 0); PG8_STAGE(PG8_SA(0, 1), a2 + hstep, voffA);
            PG8_WAIT_V(8); PG8_WAIT_L(0); PG8_BAR; PG8_MMA(0, 0, At, B0); PG8_MMA(0, 1, At, B1); PG8_BAR; PG8_SCHED;
            PG8_LDA(At, 1, 1); PG8_STAGE(PG8_SB(1, 0), b3, voffB); PG8_STAGE(PG8_SB(1, 1), b3 + hstep, voffB); PG8_STAGE(PG8_SA(1, 0), a3, voffA);
            PG8_WAIT_V(8); PG8_WAIT_L(0); PG8_BAR; PG8_MMA(1, 0, At, B0); PG8_MMA(1, 1, At, B1); PG8_BAR; PG8_SCHED;
            } else {
            PG8_LDB(B0, 0, 0); PG8_SCHED; PG8_LDA(At, 0, 0); PG8_STAGE(PG8_SA(1, 1), a1 + hstep, voffA);
            PG8_WAIT_L(8); PG8_BAR; PG8_WAIT_L(0); PG8_MMA(0, 0, At, B0); PG8_BAR; PG8_SCHED;
            PG8_LDB(B1, 0, 1); PG8_STAGE(PG8_SB(0, 0), b2, voffB);
            PG8_BAR; PG8_WAIT_L(0); PG8_MMA(0, 1, At, B1); PG8_BAR;
            PG8_LDA(At, 0, 1); PG8_STAGE(PG8_SA(0, 0), a2, voffA);
            PG8_BAR; PG8_WAIT_L(0); PG8_MMA(1, 0, At, B0); PG8_BAR; PG8_SCHED;
            PG8_STAGE(PG8_SB(0, 1), b2 + hstep, voffB);
            PG8_WAIT_V(6); PG8_BAR; PG8_MMA(1, 1, At, B1); PG8_BAR;
            PG8_LDB(B0, 1, 0); PG8_SCHED; PG8_LDA(At, 1, 0); PG8_STAGE(PG8_SA(0, 1), a2 + hstep, voffA);
            PG8_WAIT_L(8); PG8_BAR; PG8_WAIT_L(0); PG8_MMA(0, 0, At, B0); PG8_BAR; PG8_SCHED;
            PG8_LDB(B1, 1, 1); PG8_STAGE(PG8_SB(1, 0), b3, voffB);
            PG8_BAR; PG8_WAIT_L(0); PG8_MMA(0, 1, At, B1); PG8_BAR;
            PG8_LDA(At, 1, 1); PG8_STAGE(PG8_SA(1, 0), a3, voffA);
            PG8_BAR; PG8_WAIT_L(0); PG8_MMA(1, 0, At, B0); PG8_BAR; PG8_SCHED;
            PG8_STAGE(PG8_SB(1, 1), b3 + hstep, voffB);
            PG8_WAIT_V(6); PG8_BAR; PG8_MMA(1, 1, At, B1); PG8_BAR;
            }
        }
        if constexpr (ALIGN_EPI) { if (wr == 0) PG8_BAR; }
        E(acc, cur, wr, wc, fr, fq, rst);
        if (!has_next) break;
        if (nxt.pm != cur.pm) __builtin_trap();
#pragma unroll
        for (int a = 0; a < 2; ++a)
#pragma unroll
            for (int b = 0; b < 2; ++b)
#pragma unroll
                for (int m = 0; m < 4; ++m)
#pragma unroll
                    for (int n = 0; n < 2; ++n) acc[a][b][m][n] = (f32x4){0.f, 0.f, 0.f, 0.f};
        cur = nxt; cA = nA; cB = nB; ++ui;
        if constexpr (ALIGN_EPI) { if (wr == 1) PG8_BAR; }
    }
    PG8_WAIT_V(0);
    if constexpr (!ALIGN_EPI) { if (wr == 0) PG8_BAR; }
    PG8_BAR;
#undef PG8_SA
#undef PG8_SB
#undef PG8_STAGE
#undef PG8_LDA
#undef PG8_LDB
#undef PG8_MMA
#undef PG8_WAIT_V
#undef PG8_WAIT_L
#undef PG8_BAR
#undef PG8_SCHED
}
}

struct Params {
    const float* x; const float* mem; const int* pos;
    const float* ffn1_norm; const float* ffn1_w1; const float* ffn1_w3; const float* ffn1_w2;
    const float* mix_norm; const float* w_in; const float* conv_w; const float* conv_b; const float* conv_ln_g; const float* conv_ln_b;
    const float* swa_q_norm; const float* swa_k_norm; const float* swa_sinks;
    const float* mem_norm; const float* w_mem_kv; const float* mem_q_norm; const float* mem_k_norm; const float* w_out;
    const float* ffn2_norm; const float* ffn2_w1; const float* ffn2_w3; const float* ffn2_w2; const float* final_norm;
    float* out; unsigned char* ws;
};

typedef const __attribute__((address_space(4))) Params* KP;
__device__ __forceinline__ KP kparams() { KP q = (KP)__builtin_amdgcn_kernarg_segment_ptr(); asm volatile("" : "+s"(q)); return q; }

#define XB_TMO      128
#define XB_XCNT(j)  (256  + 64 * (j))
#define XB_XSUB(j)  (1280 + 64 * (j))
#define XB_XGEN(j)  (2304 + 64 * (j))
#define XB_TOP      3328
#define XB_TOPGEN   3392
#define XCD_BAR_WORDS 3456
#define XB_SPIN_CAP (1u << 20)
__device__ __forceinline__ unsigned xb_ld(unsigned* p)              { return __hip_atomic_load(p, __ATOMIC_RELAXED, __HIP_MEMORY_SCOPE_AGENT); }
__device__ __forceinline__ unsigned xb_add(unsigned* p, unsigned v) { return __hip_atomic_fetch_add(p, v, __ATOMIC_RELAXED, __HIP_MEMORY_SCOPE_AGENT); }
__device__ __forceinline__ unsigned xb_xcc_id() { return (unsigned)__builtin_amdgcn_s_getreg((3 << 11) | 20) & 0xFu; }
#define XB_SPIN(cond, bar) do { unsigned _sp = 0; while (cond) { __builtin_amdgcn_s_sleep(1); \
    if ((++_sp & 255u) == 0u) { if (xb_ld(&(bar)[XB_TMO])) break; if (_sp > XB_SPIN_CAP) { atomicAdd(&(bar)[XB_TMO], 1u); break; } } } } while (0)
__device__ __forceinline__ void xcd_barrier_complete(unsigned* bar, unsigned x, unsigned& nloc, unsigned& nx) {
    const unsigned G = gridDim.x * gridDim.y * gridDim.z;
    unsigned sum, cnt, mine, sp = 0u;
    for (;;) {
        sum = 0u; cnt = 0u; mine = 0u;
#pragma unroll
        for (unsigned j = 0; j < 16; ++j) { const unsigned c = xb_ld(&bar[XB_XCNT(j)]); sum += c; cnt += (c > 0u) ? 1u : 0u; mine = (j == x) ? c : mine; }
        if (sum == G) break;
        __builtin_amdgcn_s_sleep(1);
        if ((++sp & 255u) == 0u) { if (xb_ld(&bar[XB_TMO])) break; if (sp > XB_SPIN_CAP) { atomicAdd(&bar[XB_TMO], 1u); break; } }
    }
    nloc = mine > 0u ? mine : 1u; nx = cnt > 0u ? cnt : 1u;
}
__device__ __forceinline__ void xcd_barrier(LAS unsigned char* lds) {
    asm volatile("s_waitcnt vmcnt(0)" ::: "memory");
    __syncthreads();
    if (opaque_tid() == 0) {
        unsigned* bar = (unsigned*)(kparams()->ws + WS_CTL);
        volatile LAS unsigned* st = (volatile LAS unsigned*)(lds + LDS_MISC);
        const unsigned x = xb_xcc_id();
        __builtin_amdgcn_s_waitcnt(0);
        unsigned nloc = st[0], nx = st[1];
        if (nloc == 0u) { xcd_barrier_complete(bar, x, nloc, nx); st[0] = nloc; st[1] = nx; }
        const unsigned old = xb_add(&bar[XB_XSUB(x)], 1u);
        const unsigned gen = old / nloc;
        if (old + 1u == (gen + 1u) * nloc) {
            __builtin_amdgcn_fence(__ATOMIC_RELEASE, "agent");
            asm volatile("s_waitcnt vmcnt(0)" ::: "memory");
            const unsigned og = xb_add(&bar[XB_TOP], 1u);
            const unsigned tg = og / nx;
            if (og + 1u == (tg + 1u) * nx) xb_add(&bar[XB_TOPGEN], 1u);
            else XB_SPIN(xb_ld(&bar[XB_TOPGEN]) == tg, bar);
            __builtin_amdgcn_fence(__ATOMIC_ACQUIRE, "agent");
            xb_add(&bar[XB_XGEN(x)], 1u);
            asm volatile("s_waitcnt vmcnt(0)" ::: "memory");
        } else {
            XB_SPIN(xb_ld(&bar[XB_XGEN(x)]) == gen, bar);
            __builtin_amdgcn_fence(__ATOMIC_ACQUIRE, "agent");
            asm volatile("s_waitcnt vmcnt(0)" ::: "memory");
        }
    }
    __syncthreads();
}

constexpr int TR_L_ITEMS = 704 * 6 + 416 + 256 + 128, TR_ITEMS = DEPTH * TR_L_ITEMS;
struct TrDesc { const float* W; bf16_t* WT; const float* gain; int K, N, il, row_off, item; };
constexpr int TR_L_MAIN = TR_L_ITEMS - 128;
__device__ __forceinline__ TrDesc tr_desc(KP pp, int l, int r) {
    unsigned char* ws = pp->ws; unsigned char* wl = ws + WS_W + (size_t)l * SZ_LAYER;
    const size_t o13 = (size_t)l * DM * DFF;
    TrDesc d;
    if (r < 704) { d = TrDesc{pp->ffn1_w1 + o13, (bf16_t*)(wl + OFF_W13A), pp->ffn1_norm + l * DM, DM, DFF, 1, 0, r}; return d; } r -= 704;
    if (r < 704) { d = TrDesc{pp->ffn1_w3 + o13, (bf16_t*)(wl + OFF_W13A), pp->ffn1_norm + l * DM, DM, DFF, 1, 128, r}; return d; } r -= 704;
    if (r < 704) { d = TrDesc{pp->ffn1_w2 + o13, (bf16_t*)(wl + OFF_W2A), nullptr, DFF, DM, 0, 0, r}; return d; } r -= 704;
    if (r < 416) { d = TrDesc{pp->w_in + (size_t)l * DM * DIN, (bf16_t*)(wl + OFF_WIN), pp->mix_norm + l * DM, DM, DIN, 0, 0, r}; return d; } r -= 416;
    if (r < 256) { d = TrDesc{pp->w_out + (size_t)l * DM * DM, (bf16_t*)(wl + OFF_WOUT), nullptr, DM, DM, 0, 0, r}; return d; } r -= 256;
    if (r < 704) { d = TrDesc{pp->ffn2_w1 + o13, (bf16_t*)(wl + OFF_W13B), pp->ffn2_norm + l * DM, DM, DFF, 1, 0, r}; return d; } r -= 704;
    if (r < 704) { d = TrDesc{pp->ffn2_w3 + o13, (bf16_t*)(wl + OFF_W13B), pp->ffn2_norm + l * DM, DM, DFF, 1, 128, r}; return d; } r -= 704;
    if (r < 704) { d = TrDesc{pp->ffn2_w2 + o13, (bf16_t*)(wl + OFF_W2B), nullptr, DFF, DM, 0, 0, r}; return d; } r -= 704;
    d = TrDesc{pp->w_mem_kv + (size_t)l * DM * 512, (bf16_t*)(ws + WS_WM), pp->mem_norm + l * DM, DM, 512, 0, l * 512, r}; return d;
}
__device__ __forceinline__ void tr_load(const TrDesc& d, int lane, f32x4 (&v)[16]) {
    const int nblk = d.N >> 6, kb = d.item / nblk, nb = d.item - kb * nblk;
    const float* src = d.W + (size_t)(64 * kb + 16 * (lane >> 4)) * d.N + 64 * nb + 4 * (lane & 15);
#pragma unroll
    for (int i = 0; i < 16; ++i) v[i] = __builtin_nontemporal_load((const f32x4*)(src + (size_t)i * d.N));
}
__device__ __forceinline__ void tr_store(const TrDesc& d, int lane, f32x4 (&v)[16]) {
    const int nblk = d.N >> 6, kb = d.item / nblk, nb = d.item - kb * nblk, kk = 64 * kb + 16 * (lane >> 4), nn = 64 * nb + 4 * (lane & 15);
    if (d.gain) {
#pragma unroll
        for (int q = 0; q < 4; ++q) { const f32x4 gq = *(const f32x4*)(d.gain + kk + 4 * q);
#pragma unroll
            for (int e = 0; e < 4; ++e) v[4 * q + e] = v[4 * q + e] * gq[e]; }
    }
#pragma unroll
    for (int j = 0; j < 4; ++j) {
        const int n = nn + j, drow = d.row_off + (d.il ? (((n >> 7) << 8) + (n & 127)) : n);
        u32x4 a, b;
        a.x = cvt_pk_bf16(v[0][j], v[1][j]); a.y = cvt_pk_bf16(v[2][j], v[3][j]); a.z = cvt_pk_bf16(v[4][j], v[5][j]); a.w = cvt_pk_bf16(v[6][j], v[7][j]);
        b.x = cvt_pk_bf16(v[8][j], v[9][j]); b.y = cvt_pk_bf16(v[10][j], v[11][j]); b.z = cvt_pk_bf16(v[12][j], v[13][j]); b.w = cvt_pk_bf16(v[14][j], v[15][j]);
        u32x4* o = (u32x4*)(d.WT + (size_t)drow * d.K + kk);
        store16_wt(o, a); store16_wt(o + 1, b);
    }
}
__device__ __forceinline__ float row_to_bf16(const float* xrow, bf16_t* orow, int lane) {
    const f32x4* xr = (const f32x4*)xrow + lane; float s = 0.f; f32x4 v[4];
#pragma unroll
    for (int j = 0; j < 4; ++j) { v[j] = xr[64 * j]; s += (v[j][0] * v[j][0] + v[j][1] * v[j][1]) + (v[j][2] * v[j][2] + v[j][3] * v[j][3]); }
    u32x2* o8 = (u32x2*)orow + lane;
#pragma unroll
    for (int j = 0; j < 4; ++j) { u32x2 w; w.x = cvt_pk_bf16(v[j][0], v[j][1]); w.y = cvt_pk_bf16(v[j][2], v[j][3]); o8[64 * j] = w; }
    return wave_sum(s);
}

__device__ __forceinline__ void convert_items(KP pp, int l, int r0, int r1, int gw, int NGW, int lane) {
    int g = r0 + gw; TrDesc d; f32x4 v[16];
    if (g >= r1) return;
    d = tr_desc(pp, l, g); tr_load(d, lane, v);
#pragma unroll 1
    while (g < r1) {
        const int gn = g + NGW; TrDesc dn = d; f32x4 vn[16];
        if (gn < r1) { dn = tr_desc(pp, l, gn); tr_load(dn, lane, vn); }
        else {
#pragma unroll
            for (int i = 0; i < 16; ++i) vn[i] = v[i];
        }
        tr_store(d, lane, v);
#pragma unroll
        for (int i = 0; i < 16; ++i) v[i] = vn[i];
        d = dn; g = gn;
    }
}
__device__ __forceinline__ void convert_in_tail(int lnext, int kmin, int f0, int f1, int skip_last = 0) {
    if (lnext >= DEPTH) return;
    const int bid = opaque_bid(), j = bid >> 3, k = j >> 3;
    if (k < kmin || j >= 32 - skip_last) return;
    const KP pp = kparams();
    const int tid = opaque_tid(), lane = tid & 63, wave = tid >> 6;
    const int cidx = (j - 8 * kmin) * 8 + (bid & 7), ncu = (4 - kmin) * 64 - 8 * skip_last;
    convert_items(pp, lnext, TR_L_MAIN * f0 / 16, TR_L_MAIN * f1 / 16, cidx * 8 + wave, ncu * 8, lane);
}
__device__ __forceinline__ void prologue(LAS unsigned char* lds) {
    const KP pp = kparams();
    const int tid = opaque_tid(), lane = tid & 63, wave = tid >> 6;
    const int G = gridDim.x, gw = blockIdx.x * 8 + wave, NGW = G * 8;
    unsigned char* ws = pp->ws;
    convert_items(pp, 0, 0, TR_L_ITEMS, gw, NGW, lane);
#pragma unroll 1
    for (int l = 1; l < DEPTH; ++l) {
        const int shift = (TR_L_ITEMS + 128 * (l - 1)) % NGW;
        convert_items(pp, l, TR_L_MAIN, TR_L_ITEMS, (gw + NGW - shift) % NGW, NGW, lane);
    }
#pragma unroll 1
    for (int l = 0; l < DEPTH; ++l) {
        unsigned char* wl = ws + WS_W + (size_t)l * SZ_LAYER;
        u32x4* z = (u32x4*)(wl + OFF_WIN + (size_t)DIN * DM * 2); const int n16 = (DINP - DIN) * DM * 2 / 16;
        for (int i = blockIdx.x * 512 + tid; i < n16; i += G * 512) z[i] = (u32x4){0u, 0u, 0u, 0u};
    }
    {
        bf16_t* RB = (bf16_t*)(ws + WS_RB); float* PB = (float*)(ws + WS_PB);
        for (int m0 = gw * 4; m0 < M; m0 += NGW * 4) {
            f32x4 v[4][4];
#pragma unroll
            for (int r = 0; r < 4; ++r)
#pragma unroll
                for (int j = 0; j < 4; ++j) v[r][j] = __builtin_nontemporal_load((const f32x4*)(pp->x + (size_t)(m0 + r) * DM) + lane + 64 * j);
#pragma unroll
            for (int r = 0; r < 4; ++r) {
                float sq = 0.f; u32x2* o8 = (u32x2*)(RB + (size_t)(m0 + r) * DM) + lane;
#pragma unroll
                for (int j = 0; j < 4; ++j) { const f32x4 t = v[r][j]; sq += (t[0] * t[0] + t[1] * t[1]) + (t[2] * t[2] + t[3] * t[3]);
                    u32x2 w; w.x = cvt_pk_bf16(t[0], t[1]); w.y = cvt_pk_bf16(t[2], t[3]); o8[64 * j] = w; }
                sq = wave_sum(sq);
                if (lane < 16) PB[(size_t)(m0 + r) * 16 + lane] = lane == 0 ? sq : 0.f;
            }
        }
        bf16_t* MB = (bf16_t*)(ws + WS_MEMB); float* PM = (float*)(ws + WS_PM);
        for (int m = gw; m < MROWS; m += NGW) { const float s = row_to_bf16(pp->mem + (size_t)m * DM, MB + (size_t)m * DM, lane); if (lane < 16) PM[(size_t)m * 16 + lane] = lane == 0 ? s : 0.f; }
    }
}

constexpr int KS_STRIDE = 144, VT_STRIDE = 544;
constexpr int LDS_KS = 0, LDS_VT = 256 * KS_STRIDE;
constexpr float QSCALE = 0.125f * 1.4426950408889634f;

struct RowTask { bf16x8 lo, hi; int pos; };
template <bool ROPE>
__device__ __forceinline__ void row_issue(RowTask& t, const bf16_t* rowp, const int* posp, int c) {
    t.lo = *(const bf16x8*)(rowp + 8 * c); t.hi = *(const bf16x8*)(rowp + 32 + 8 * c);
    if (ROPE) t.pos = *posp;
}
__device__ __forceinline__ void rope_freqs(int c, float (&f)[8]) {
#pragma unroll
    for (int e = 0; e < 8; ++e) f[e] = __builtin_amdgcn_exp2f(-(float)(8 * c + e) * (13.287712379549449f / 32.0f)) * 0.15915494309189535f;
}
template <bool ROPE>
__device__ __forceinline__ void row_finish(const RowTask& t, bool valid, const f32x4 (&g)[4], const float (&rf)[8], float scale, int m1, int m2, u32x4& w1, u32x4& w2) {
    float x1[8], x2[8]; float ss = 0.f;
#pragma unroll
    for (int e = 0; e < 8; ++e) { x1[e] = valid ? bf2f(t.lo[e]) : 0.f; x2[e] = valid ? bf2f(t.hi[e]) : 0.f; ss += x1[e] * x1[e] + x2[e] * x2[e]; }
    ss += __shfl_xor(ss, m1); ss += __shfl_xor(ss, m2);
    const float rs = scale * __builtin_amdgcn_rsqf(ss * (1.0f / 64.0f) + EPS);
#pragma unroll
    for (int e = 0; e < 4; ++e) { x1[e] *= rs * g[0][e]; x1[4 + e] *= rs * g[1][e]; x2[e] *= rs * g[2][e]; x2[4 + e] *= rs * g[3][e]; }
    if (ROPE) {
        const float pf = (float)t.pos;
#pragma unroll
        for (int e = 0; e < 8; ++e) { const float rev = __builtin_amdgcn_fractf(pf * rf[e]); const float cc = __builtin_amdgcn_cosf(rev), sn = __builtin_amdgcn_sinf(rev);
            const float a = x1[e], b = x2[e]; x1[e] = a * cc - b * sn; x2[e] = b * cc + a * sn; }
    }
    w1.x = cvt_pk_bf16(x1[0], x1[1]); w1.y = cvt_pk_bf16(x1[2], x1[3]); w1.z = cvt_pk_bf16(x1[4], x1[5]); w1.w = cvt_pk_bf16(x1[6], x1[7]);
    w2.x = cvt_pk_bf16(x2[0], x2[1]); w2.y = cvt_pk_bf16(x2[2], x2[3]); w2.z = cvt_pk_bf16(x2[4], x2[5]); w2.w = cvt_pk_bf16(x2[6], x2[7]);
}
__device__ __forceinline__ void load_gains(const float* g, int c, f32x4 (&o)[4]) { o[0] = *(const f32x4*)(g + 8 * c); o[1] = *(const f32x4*)(g + 8 * c + 4); o[2] = *(const f32x4*)(g + 32 + 8 * c); o[3] = *(const f32x4*)(g + 36 + 8 * c); }
__device__ __forceinline__ void vt_store(LAS unsigned char* lds, bf16x8 v, bool valid, int r, int c) {
#pragma unroll
    for (int e = 0; e < 8; ++e) *(LAS short*)(lds + LDS_VT + (8 * c + e) * VT_STRIDE + 2 * r) = valid ? v[e] : (short)0;
}

template <int NT, bool SWA, int NQ>
__device__ __forceinline__ void attn_multi(LAS const unsigned char* lds, const bf16x8 (&q0)[NQ], const bf16x8 (&q1)[NQ], int kt0, int i0, bool first_blk, const float (&sink2)[NQ], bf16_t* const (&orow)[NQ], int fr, int fq) {
    f32x4 s[NQ][NT];
    {
        const LAS unsigned char* kp = lds + LDS_KS + (16 * kt0 + fr) * KS_STRIDE + 16 * fq;
        bf16x8 kc0 = *(const LAS bf16x8*)kp, kc1 = *(const LAS bf16x8*)(kp + 64);
#pragma unroll
        for (int t = 0; t < NT; ++t) {
            bf16x8 kn0 = kc0, kn1 = kc1;
            if (t + 1 < NT) { kn0 = *(const LAS bf16x8*)(kp + (t + 1) * 16 * KS_STRIDE); kn1 = *(const LAS bf16x8*)(kp + (t + 1) * 16 * KS_STRIDE + 64); }
#pragma unroll
            for (int n = 0; n < NQ; ++n) {
                f32x4 a = {0.f, 0.f, 0.f, 0.f};
                a = __builtin_amdgcn_mfma_f32_16x16x32_bf16(kc0, q0[n], a, 0, 0, 0);
                a = __builtin_amdgcn_mfma_f32_16x16x32_bf16(kc1, q1[n], a, 0, 0, 0);
                s[n][t] = a;
            }
            kc0 = kn0; kc1 = kn1;
        }
    }
    float l[NQ];
#pragma unroll
    for (int n = 0; n < NQ; ++n) {
        float mx = -INFINITY;
#pragma unroll
        for (int t = 0; t < NT; ++t)
#pragma unroll
            for (int j = 0; j < 4; ++j) {
                if (SWA) { const int kj = 16 * (kt0 + t) + 4 * fq + j, i = i0 + fr; const bool ok = (kj >= i + 1) && (kj <= i + 128) && (!first_blk || kj >= 128); if (!ok) s[n][t][j] = -INFINITY; }
                mx = fmaxf(mx, s[n][t][j]);
            }
        mx = fmaxf(mx, __shfl_xor(mx, 16)); mx = fmaxf(mx, __shfl_xor(mx, 32));
        float ls = 0.f;
#pragma unroll
        for (int t = 0; t < NT; ++t)
#pragma unroll
            for (int j = 0; j < 4; ++j) { const float pv = __builtin_amdgcn_exp2f(s[n][t][j] - mx); ls += pv; s[n][t][j] = pv; }
        ls += __shfl_xor(ls, 16); ls += __shfl_xor(ls, 32);
        if (SWA) ls += __builtin_amdgcn_exp2f(sink2[n] - mx);
        l[n] = ls;
    }
    f32x4 o[NQ][4];
#pragma unroll
    for (int n = 0; n < NQ; ++n)
#pragma unroll
        for (int dt = 0; dt < 4; ++dt) o[n][dt] = (f32x4){0.f, 0.f, 0.f, 0.f};
    constexpr int NSP = (NT + 1) / 2;
    const LAS unsigned char* vbase = lds + LDS_VT + fr * VT_STRIDE + 2 * (16 * kt0 + 4 * fq);
    u32x2 va[4][2], vn[4][2];
#pragma unroll
    for (int dt = 0; dt < 4; ++dt) { va[dt][0] = *(const LAS u32x2*)(vbase + 16 * dt * VT_STRIDE); va[dt][1] = *(const LAS u32x2*)(vbase + 16 * dt * VT_STRIDE + 32); }
#pragma unroll
    for (int sp = 0; sp < NSP; ++sp) {
        if (sp + 1 < NSP) {
#pragma unroll
            for (int dt = 0; dt < 4; ++dt) { vn[dt][0] = *(const LAS u32x2*)(vbase + 16 * dt * VT_STRIDE + 64 * (sp + 1)); vn[dt][1] = *(const LAS u32x2*)(vbase + 16 * dt * VT_STRIDE + 64 * (sp + 1) + 32); }
        }
        bf16x8 pb[NQ];
#pragma unroll
        for (int n = 0; n < NQ; ++n) {
            u32x4 pw; pw.x = cvt_pk_bf16(s[n][2 * sp][0], s[n][2 * sp][1]); pw.y = cvt_pk_bf16(s[n][2 * sp][2], s[n][2 * sp][3]);
            if (2 * sp + 1 < NT) { pw.z = cvt_pk_bf16(s[n][(2 * sp + 1) % NT][0], s[n][(2 * sp + 1) % NT][1]); pw.w = cvt_pk_bf16(s[n][(2 * sp + 1) % NT][2], s[n][(2 * sp + 1) % NT][3]); } else { pw.z = 0u; pw.w = 0u; }
            pb[n] = __builtin_bit_cast(bf16x8, pw);
        }
#pragma unroll
        for (int dt = 0; dt < 4; ++dt) {
            u32x4 vw; vw.x = va[dt][0].x; vw.y = va[dt][0].y; vw.z = va[dt][1].x; vw.w = va[dt][1].y;
            const bf16x8 vf = __builtin_bit_cast(bf16x8, vw);
#pragma unroll
            for (int n = 0; n < NQ; ++n) o[n][dt] = __builtin_amdgcn_mfma_f32_16x16x32_bf16(vf, pb[n], o[n][dt], 0, 0, 0);
        }
        if (sp + 1 < NSP) {
#pragma unroll
            for (int dt = 0; dt < 4; ++dt) { va[dt][0] = vn[dt][0]; va[dt][1] = vn[dt][1]; }
        }
    }
#pragma unroll
    for (int n = 0; n < NQ; ++n) {
        const float inv = __builtin_amdgcn_rcpf(l[n]);
#pragma unroll
        for (int dt = 0; dt < 4; ++dt) { u32x2 w; w.x = cvt_pk_bf16(o[n][dt][0] * inv, o[n][dt][1] * inv); w.y = cvt_pk_bf16(o[n][dt][2] * inv, o[n][dt][3] * inv); store8_wt(orow[n] + 16 * dt + 4 * fq, w); }
    }
}

__device__ __forceinline__ void swa_unit(LAS unsigned char* lds, int l, int unit) {
    const KP pp = kparams(); struct { unsigned char* ws; const float* swa_k_norm; const float* swa_q_norm; const float* swa_sinks; } p = {pp->ws, pp->swa_k_norm, pp->swa_q_norm, pp->swa_sinks};
    const int tid = opaque_tid(), lane = tid & 63, wave = tid >> 6, fr = lane & 15, fq = lane >> 4;
    const int kvh = unit & 1, blk = (unit >> 1) & 63, b = unit >> 7;
    const bf16_t* P = (const bf16_t*)(p.ws + WS_P); bf16_t* Y = (bf16_t*)(p.ws + WS_Y);
    const int* posv = pp->pos;
    const long row0 = (long)b * SEQ + (long)blk * 128 - 128;
    const int row_lo = blk == 0 ? 128 : 0;
    RowTask kt[2], qt[3]; bf16x8 vv[4]; f32x4 gk[4], gq[4]; float sink2[3];
    const int kc = tid & 3;
#pragma unroll
    for (int it = 0; it < 2; ++it) { const int r = (tid + it * 512) >> 2, rr = r < row_lo ? row_lo : r; const long m = row0 + rr;
        row_issue<true>(kt[it], P + m * DINP + PC_K + kvh * 64, posv + m, kc); }
#pragma unroll
    for (int it = 0; it < 4; ++it) { const int task = tid + it * 512, r = task & 255, c = task >> 8, rr = r < row_lo ? row_lo : r;
        vv[it] = *(const bf16x8*)(P + (row0 + rr) * DINP + PC_V + kvh * 64 + 8 * c); }
#pragma unroll
    for (int gi3 = 0; gi3 < 3; ++gi3) { const int gidx = wave + 8 * gi3, g = gidx >> 3, gi = gidx & 7, hq = kvh * 3 + g;
        const long tok = (long)b * SEQ + (long)blk * 128 + 16 * gi + fr;
        row_issue<true>(qt[gi3], P + tok * DINP + PC_Q + hq * 64, posv + tok, fq);
        sink2[gi3] = p.swa_sinks[l * 6 + hq] * 1.4426950408889634f; }
    load_gains(p.swa_k_norm + l * 64, kc, gk); load_gains(p.swa_q_norm + l * 64, fq, gq);
    float rfk[8], rfq[8]; rope_freqs(kc, rfk); rope_freqs(fq, rfq);
#pragma unroll
    for (int it = 0; it < 2; ++it) { const int r = (tid + it * 512) >> 2; u32x4 w1, w2;
        row_finish<true>(kt[it], r >= row_lo, gk, rfk, 1.0f, 1, 2, w1, w2);
        *(LAS u32x4*)(lds + LDS_KS + r * KS_STRIDE + 16 * kc) = w1; *(LAS u32x4*)(lds + LDS_KS + r * KS_STRIDE + 64 + 16 * kc) = w2; }
#pragma unroll
    for (int it = 0; it < 4; ++it) { const int task = tid + it * 512, r = task & 255, c = task >> 8; vt_store(lds, vv[it], r >= row_lo, r, c); }
    if (tid < 128) { const unsigned z = opaque_zero(); *(LAS u32x4*)(lds + LDS_VT + (tid >> 1) * VT_STRIDE + 512 + 16 * (tid & 1)) = (u32x4){z, z, z, z}; }
    bf16x8 q0[3], q1[3];
#pragma unroll
    for (int gi3 = 0; gi3 < 3; ++gi3) { u32x4 w1, w2; row_finish<true>(qt[gi3], true, gq, rfq, QSCALE, 16, 32, w1, w2); q0[gi3] = __builtin_bit_cast(bf16x8, w1); q1[gi3] = __builtin_bit_cast(bf16x8, w2); }
    __syncthreads();
    {
        const long tok = (long)b * SEQ + (long)blk * 128 + 16 * wave + fr;
        bf16_t* const orow[3] = {Y + tok * DM + YC_SWA + (kvh * 3 + 0) * 64, Y + tok * DM + YC_SWA + (kvh * 3 + 1) * 64, Y + tok * DM + YC_SWA + (kvh * 3 + 2) * 64};
        attn_multi<9, true, 3>(lds, q0, q1, wave, 16 * wave, blk == 0, sink2, orow, fr, fq);
    }
    __syncthreads();
}
__device__ __forceinline__ void mem_unit(LAS unsigned char* lds, int l, int unit) {
    const KP pp = kparams(); struct { unsigned char* ws; const float* mem_k_norm; const float* mem_q_norm; } p = {pp->ws, pp->mem_k_norm, pp->mem_q_norm};
    const int tid = opaque_tid(), lane = tid & 63, wave = tid >> 6, fr = lane & 15, fq = lane >> 4;
    const int h = unit & 3, blk = (unit >> 2) & 31, b = unit >> 7;
    const bf16_t* P = (const bf16_t*)(p.ws + WS_P); bf16_t* Y = (bf16_t*)(p.ws + WS_Y);
    const bf16_t* MKV = (const bf16_t*)(p.ws + WS_MKV) + (long)b * MEMLEN * 2048 + l * 512 + h * 64;
    RowTask kt[2], qt[2]; bf16x8 vv[4]; f32x4 gk[4], gq[4];
    const int kc = tid & 3;
#pragma unroll
    for (int it = 0; it < 2; ++it) { const int r = (tid + it * 512) >> 2; row_issue<false>(kt[it], MKV + (long)r * 2048, nullptr, kc); }
#pragma unroll
    for (int it = 0; it < 4; ++it) { const int task = tid + it * 512, r = task & 255, c = task >> 8; vv[it] = *(const bf16x8*)(MKV + (long)r * 2048 + 256 + 8 * c); }
#pragma unroll
    for (int g2 = 0; g2 < 2; ++g2) { const long tok = (long)b * SEQ + (long)blk * 256 + 16 * (wave + 8 * g2) + fr; row_issue<false>(qt[g2], P + tok * DINP + PC_QM + h * 64, nullptr, fq); }
    load_gains(p.mem_k_norm + l * 64, kc, gk); load_gains(p.mem_q_norm + l * 64, fq, gq);
    const float rf0[8] = {0.f, 0.f, 0.f, 0.f, 0.f, 0.f, 0.f, 0.f};
#pragma unroll
    for (int it = 0; it < 2; ++it) { const int r = (tid + it * 512) >> 2; u32x4 w1, w2;
        row_finish<false>(kt[it], true, gk, rf0, 1.0f, 1, 2, w1, w2);
        *(LAS u32x4*)(lds + LDS_KS + r * KS_STRIDE + 16 * kc) = w1; *(LAS u32x4*)(lds + LDS_KS + r * KS_STRIDE + 64 + 16 * kc) = w2; }
#pragma unroll
    for (int it = 0; it < 4; ++it) { const int task = tid + it * 512, r = task & 255, c = task >> 8; vt_store(lds, vv[it], true, r, c); }
    if (tid < 128) { const unsigned z = opaque_zero(); *(LAS u32x4*)(lds + LDS_VT + (tid >> 1) * VT_STRIDE + 512 + 16 * (tid & 1)) = (u32x4){z, z, z, z}; }
    bf16x8 q0[2], q1[2];
#pragma unroll
    for (int g2 = 0; g2 < 2; ++g2) { u32x4 w1, w2; row_finish<false>(qt[g2], true, gq, rf0, QSCALE, 16, 32, w1, w2); q0[g2] = __builtin_bit_cast(bf16x8, w1); q1[g2] = __builtin_bit_cast(bf16x8, w2); }
    __syncthreads();
    {
        const long tok = (long)b * SEQ + (long)blk * 256 + 16 * wave + fr;
        bf16_t* const orow[2] = {Y + tok * DM + YC_MEM + h * 64, Y + (tok + 128) * DM + YC_MEM + h * 64};
        const float nosink[2] = {0.f, 0.f};
        attn_multi<16, false, 2>(lds, q0, q1, 0, 0, false, nosink, orow, fr, fq);
    }
    __syncthreads();
}
typedef __bf16 v2bf16 __attribute__((ext_vector_type(2)));
constexpr int LDS_CG = 0, LDS_CW = 94 * 768, LDS_CPART = LDS_CW + 16 * CONVC * 4, LDS_CSTAT = LDS_CPART + 48 * 65 * 8;
static_assert(LDS_CSTAT + 512 <= 131072, "conv LDS map");
__device__ __forceinline__ float dot2bf(unsigned a, unsigned b, float c) { return __builtin_amdgcn_fdot2_f32_bf16(__builtin_bit_cast(v2bf16, a), __builtin_bit_cast(v2bf16, b), c, false); }
__device__ __forceinline__ void conv_unit(LAS unsigned char* lds, int l, int unit) {
    const KP pp = kparams(); struct { unsigned char* ws; const float* conv_w; const float* conv_b; const float* conv_ln_g; const float* conv_ln_b; } p = {pp->ws, pp->conv_w, pp->conv_b, pp->conv_ln_g, pp->conv_ln_b};
    const int tid = opaque_tid();
    const int tb = unit & 127, b = unit >> 7, t0 = tb * 64;
    const bf16_t* P = (const bf16_t*)(p.ws + WS_P); bf16_t* Y = (bf16_t*)(p.ws + WS_Y);
    const float* cw = p.conv_w + (size_t)l * CONVW * CONVC; const float* cb = p.conv_b + l * CONVC;
    const float* lg = p.conv_ln_g + l * CONVC; const float* lb = p.conv_ln_b + l * CONVC;
    {
        bf16x8 av[9], gv[9]; float w0[12], w1[12];
#pragma unroll
        for (int it = 0; it < 12; ++it) { const int idx = tid + it * 512, jp = idx / CONVC, c = idx - jp * CONVC;
            w0[it] = cw[(2 * jp) * CONVC + c]; w1[it] = (2 * jp + 1 < CONVW) ? cw[(2 * jp + 1) * CONVC + c] : 0.f; }
        const unsigned z = opaque_zero(); const bf16x8 zv = __builtin_bit_cast(bf16x8, (u32x4){z, z, z, z});
#pragma unroll
        for (int it = 0; it < 9; ++it) {
            const int task = tid + it * 512, row = task / 48, ch = task - row * 48, t = t0 - 30 + row;
            av[it] = zv; gv[it] = zv;
            if (task < 94 * 48 && t >= 0) { const bf16_t* pr = P + ((long)b * SEQ + t) * DINP + 8 * ch; av[it] = *(const bf16x8*)(pr + PC_A); gv[it] = *(const bf16x8*)(pr + PC_G); }
        }
#pragma unroll
        for (int it = 0; it < 12; ++it) *(LAS unsigned*)(lds + LDS_CW + 4 * (tid + it * 512)) = cvt_pk_bf16(w0[it], w1[it]);
#pragma unroll
        for (int it = 0; it < 9; ++it) {
            const int task = tid + it * 512, row = task / 48, ch = task - row * 48;
            float y[8];
#pragma unroll
            for (int e = 0; e < 8; ++e) y[e] = bf2f(av[it][e]) * sigmoid_f(bf2f(gv[it][e]));
            u32x4 o; o.x = cvt_pk_bf16(y[0], y[1]); o.y = cvt_pk_bf16(y[2], y[3]); o.z = cvt_pk_bf16(y[4], y[5]); o.w = cvt_pk_bf16(y[6], y[7]);
            if (task < 94 * 48) *(LAS u32x4*)(lds + LDS_CG + row * 768 + 16 * ch) = o;
        }
    }
    __syncthreads();
    const int oct = tid % 48, grp = tid / 48;
    float acc[8][8];
    if (tid < 384) {
        const f32x4 b0 = *(const f32x4*)(cb + 8 * oct), b1 = *(const f32x4*)(cb + 8 * oct + 4);
#pragma unroll
        for (int tt = 0; tt < 8; ++tt)
#pragma unroll
            for (int e = 0; e < 4; ++e) { acc[tt][e] = b0[e]; acc[tt][4 + e] = b1[e]; }
#pragma unroll 1
        for (int jp = 0; jp < 16; ++jp) {
            const u32x4 wa = *(const LAS u32x4*)(lds + LDS_CW + (jp * CONVC + 8 * oct) * 4), wb = *(const LAS u32x4*)(lds + LDS_CW + (jp * CONVC + 8 * oct) * 4 + 16);
            u32x4 gr[9];
#pragma unroll
            for (int i = 0; i < 9; ++i) gr[i] = *(const LAS u32x4*)(lds + LDS_CG + (grp * 8 + 2 * jp + i) * 768 + 16 * oct);
#pragma unroll
            for (int tt = 0; tt < 8; ++tt) {
#pragma unroll
                for (int k = 0; k < 4; ++k) {
                    const unsigned lo = __builtin_amdgcn_perm(gr[tt + 1][k], gr[tt][k], 0x05040100u), hi = __builtin_amdgcn_perm(gr[tt + 1][k], gr[tt][k], 0x07060302u);
                    const unsigned wl = k < 2 ? wa[2 * k] : wb[2 * k - 4], wh = k < 2 ? wa[2 * k + 1] : wb[2 * k - 3];
                    acc[tt][2 * k] = dot2bf(lo, wl, acc[tt][2 * k]); acc[tt][2 * k + 1] = dot2bf(hi, wh, acc[tt][2 * k + 1]);
                }
            }
        }
#pragma unroll
        for (int tt = 0; tt < 8; ++tt) {
            float s = 0.f, q = 0.f;
#pragma unroll
            for (int e = 0; e < 8; ++e) { s += acc[tt][e]; q += acc[tt][e] * acc[tt][e]; }
            *(LAS f32x2*)(lds + LDS_CPART + (oct * 65 + grp * 8 + tt) * 8) = (f32x2){s, q};
        }
    }
    __syncthreads();
    if (tid < 64) {
        float s = 0.f, q = 0.f;
#pragma unroll 8
        for (int i = 0; i < 48; ++i) { const f32x2 v = *(LAS f32x2*)(lds + LDS_CPART + (i * 65 + tid) * 8); s += v.x; q += v.y; }
        const float mean = s * (1.0f / CONVC), var = fmaxf(q * (1.0f / CONVC) - mean * mean, 0.f);
        *(LAS float*)(lds + LDS_CSTAT + tid * 8) = mean; *(LAS float*)(lds + LDS_CSTAT + tid * 8 + 4) = 1.0f / sqrtf(var + EPS);
    }
    __syncthreads();
    if (tid < 384) {
        const f32x4 g0 = *(const f32x4*)(lg + 8 * oct), g1 = *(const f32x4*)(lg + 8 * oct + 4), b0 = *(const f32x4*)(lb + 8 * oct), b1 = *(const f32x4*)(lb + 8 * oct + 4);
#pragma unroll
        for (int tt = 0; tt < 8; ++tt) {
            const float mean = *(LAS float*)(lds + LDS_CSTAT + (grp * 8 + tt) * 8), rstd = *(LAS float*)(lds + LDS_CSTAT + (grp * 8 + tt) * 8 + 4);
            float y[8];
#pragma unroll
            for (int e = 0; e < 4; ++e) { y[e] = silu_f((acc[tt][e] - mean) * rstd * g0[e] + b0[e]); y[4 + e] = silu_f((acc[tt][4 + e] - mean) * rstd * g1[e] + b1[e]); }
            u32x4 w; w.x = cvt_pk_bf16(y[0], y[1]); w.y = cvt_pk_bf16(y[2], y[3]); w.z = cvt_pk_bf16(y[4], y[5]); w.w = cvt_pk_bf16(y[6], y[7]);
            store16_wt(Y + ((long)b * SEQ + t0 + grp * 8 + tt) * DM + YC_CONV + 8 * oct, w);
        }
    }
    __syncthreads();
}

__device__ __forceinline__ void phase_up(LAS unsigned char* lds, int l, int half) {
    const KP p = kparams(); unsigned char* ws = p->ws; const int G = gridDim.x, bid = opaque_bid();
    unsigned char* wl = ws + WS_W + (size_t)l * SZ_LAYER;
    pg8::Gemm g{(const bf16_t*)(ws + WS_RB), (const bf16_t*)(wl + (half ? OFF_W13B : OFF_W13A)), M, 2 * DFF, DM};
    pg8::PanelOrder S; S.init(2 * DFF, bid);
    pg8::EpiSwiglu E{(bf16_t*)(ws + WS_FF), pg8::RowScaleSpec{(const float*)(ws + WS_PA), (const float*)(ws + (half ? WS_PC : WS_PB)), (half == 0 && l > 0) ? 1 : 0, 1}};
    pg8::gemm_phase<pg8::EpiSwiglu, pg8::PanelOrder, true>(lds, g, S, E);
}
__device__ __forceinline__ void phase_memkv(LAS unsigned char* lds) {
    const KP p = kparams(); unsigned char* ws = p->ws; const int G = gridDim.x, bid = opaque_bid();
    if (bid < G - 16) return;
    pg8::Gemm gm{(const bf16_t*)(ws + WS_MEMB), (const bf16_t*)(ws + WS_WM), MROWS, 2048, DM};
    pg8::StaticOrder Sm; Sm.init(MROWS, 2048, 16, bid - (G - 16));
    pg8::EpiProj Em{(bf16_t*)(ws + WS_MKV), 2048, pg8::RowScaleSpec{(const float*)(ws + WS_PM), nullptr, 1, 0}};
    pg8::gemm_phase<pg8::EpiProj, pg8::StaticOrder, true>(lds, gm, Sm, Em);
}
__device__ __forceinline__ void phase_resid(LAS unsigned char* lds, int l, int kind) {
    const KP p = kparams(); unsigned char* ws = p->ws; const int G = gridDim.x, bid = opaque_bid();
    unsigned char* wl = ws + WS_W + (size_t)l * SZ_LAYER;
    bf16_t* RB = (bf16_t*)(ws + WS_RB);
    float* PA = (float*)(ws + WS_PA); float* PB = (float*)(ws + WS_PB); float* PC = (float*)(ws + WS_PC);
    pg8::Gemm g; pg8::EpiResid E;
    if (kind == 0) { g = pg8::Gemm{(const bf16_t*)(ws + WS_FF), (const bf16_t*)(wl + OFF_W2A), M, DM, DFF}; E = pg8::EpiResid{RB, pg8::RowScaleSpec{PA, nullptr, l == 0 ? 0 : 1, 0}, 0.5f, nullptr, PC, nullptr}; }
    else if (kind == 1) { g = pg8::Gemm{(const bf16_t*)(ws + WS_FF), (const bf16_t*)(wl + OFF_W2B), M, DM, DFF}; E = pg8::EpiResid{RB, pg8::RowScaleSpec{PA, nullptr, 0, 0}, 0.5f, p->final_norm + l * DM, PA, PB}; }
    else { g = pg8::Gemm{(const bf16_t*)(ws + WS_Y), (const bf16_t*)(wl + OFF_WOUT), M, DM, DM}; E = pg8::EpiResid{RB, pg8::RowScaleSpec{PA, nullptr, 0, 0}, 1.0f, nullptr, PC, nullptr}; }
    pg8::PanelOrder S; S.init(DM, bid);
    pg8::gemm_phase<pg8::EpiResid, pg8::PanelOrder, true>(lds, g, S, E);
}
__device__ __forceinline__ void phase_resid_final(LAS unsigned char* lds, int l) {
    const KP p = kparams(); unsigned char* ws = p->ws; const int bid = opaque_bid();
    unsigned char* wl = ws + WS_W + (size_t)l * SZ_LAYER;
    pg8::Gemm g{(const bf16_t*)(ws + WS_FF), (const bf16_t*)(wl + OFF_W2B), M, DM, DFF};
    pg8::EpiFinal E{(const bf16_t*)(ws + WS_RB), pg8::RowScaleSpec{nullptr, nullptr, 0, 0}, 0.5f, p->final_norm + l * DM, p->out, (float*)(ws + WS_XBUF), (unsigned*)(ws + WS_CTL) + CW_PANEL};
    pg8::PanelOrder S; S.init(DM, bid);
    pg8::gemm_phase<pg8::EpiFinal, pg8::PanelOrder, true>(lds, g, S, E);
}
__device__ __forceinline__ void phase_win(LAS unsigned char* lds, int l) {
    const KP p = kparams(); unsigned char* ws = p->ws; const int G = gridDim.x, bid = opaque_bid();
    unsigned char* wl = ws + WS_W + (size_t)l * SZ_LAYER;
    pg8::Gemm g{(const bf16_t*)(ws + WS_RB), (const bf16_t*)(wl + OFF_WIN), M, DINP, DM};
    pg8::PanelOrder S; S.init(DINP, bid);
    pg8::EpiProj E{(bf16_t*)(ws + WS_P), DINP, pg8::RowScaleSpec{(const float*)(ws + WS_PC), nullptr, 1, 0}};
    pg8::gemm_phase<pg8::EpiProj, pg8::PanelOrder, true>(lds, g, S, E);
}
__device__ __forceinline__ void phase_final() {
    const KP p = kparams(); unsigned char* ws = p->ws; const int G = gridDim.x, bid = opaque_bid();
    const float* PA = (const float*)(ws + WS_PA); float* R = p->out; const bf16_t* RB = (const bf16_t*)(ws + WS_RB);
    const int tid = opaque_tid(), lane = tid & 63, wave = tid >> 6, gw = bid * 8 + wave, NGW = G * 8;
    for (int m = gw; m < M; m += NGW) {
        float s = lane < 16 ? PA[(size_t)m * 16 + lane] : 0.f; s = wave_sum(s);
        const float r3 = 1.0f / sqrtf(s * (1.0f / DM) + EPS);
#pragma unroll
        for (int j = 0; j < 2; ++j) {
            const bf16x8 v = *(const bf16x8*)(RB + (size_t)m * DM + 512 * j + 8 * lane);
            f32x4* o = (f32x4*)(R + (size_t)m * DM + 512 * j + 8 * lane);
            o[0] = (f32x4){bf2f(v[0]) * r3, bf2f(v[1]) * r3, bf2f(v[2]) * r3, bf2f(v[3]) * r3};
            o[1] = (f32x4){bf2f(v[4]) * r3, bf2f(v[5]) * r3, bf2f(v[6]) * r3, bf2f(v[7]) * r3};
        }
    }
}

__global__ void __launch_bounds__(512, 2) fwd_megakernel(Params p_unused) {
    extern __shared__ __attribute__((aligned(16))) unsigned char lds_raw[];
    LAS unsigned char* lds = (LAS unsigned char*)lds_raw;
    cg::grid_group grid = cg::this_grid();
    if (threadIdx.x < 2) ((LAS unsigned*)(lds + LDS_MISC))[threadIdx.x] = 0u;
    if (threadIdx.x == 0) (void)xb_add((unsigned*)(kparams()->ws + WS_CTL) + XB_XCNT(xb_xcc_id()), 1u);
    __syncthreads();

    prologue(lds);
    if (gridDim.x == 0x7fffffffu) grid.sync();
    xcd_barrier(lds);
#pragma unroll 1
    for (int l = 0; l < DEPTH; ++l) {
        phase_up(lds, l, 0);
        if (l == 0) phase_memkv(lds);
        convert_in_tail(l + 1, 2, 0, 6, l == 0 ? 2 : 0);
        xcd_barrier(lds);
        phase_resid(lds, l, 0);
        xcd_barrier(lds);
        phase_win(lds, l);
        convert_in_tail(l + 1, 3, 6, 9);
        xcd_barrier(lds);
#pragma unroll 1
        for (int it = blockIdx.x; it < 768; it += gridDim.x) {
            if (it < 256) swa_unit(lds, l, it);
            else if (it < 512) conv_unit(lds, l, it - 256);
            else mem_unit(lds, l, it - 512);
        }
        xcd_barrier(lds);
        phase_resid(lds, l, 2);
        xcd_barrier(lds);
        phase_up(lds, l, 1);
        convert_in_tail(l + 1, 2, 9, 16);
        xcd_barrier(lds);
        if (l < DEPTH - 1) { phase_resid(lds, l, 1); xcd_barrier(lds); }
        else phase_resid_final(lds, l);
    }
}

extern "C" void kernel_launch(void* const* d_in, const int* in_sizes, int n_in, void* d_out, int out_size, void* d_ws, size_t ws_size, hipStream_t stream) {
    static int grid = 0;
    if (grid == 0) {
        if (n_in != 26 || in_sizes[0] != M * DM || out_size != M * DM || ws_size < WS_END) { fprintf(stderr, "kernel_launch: unexpected shapes (n_in %d in0 %d out %d ws %zu)\n", n_in, n_in > 0 ? in_sizes[0] : -1, out_size, ws_size); grid = -1; return; }
        int dev = 0, cus = 0, per_cu = 0;
        hipGetDevice(&dev);
        hipDeviceGetAttribute(&cus, hipDeviceAttributeMultiprocessorCount, dev);
        hipFuncSetAttribute((const void*)fwd_megakernel, hipFuncAttributeMaxDynamicSharedMemorySize, LDS_BYTES);
        hipOccupancyMaxActiveBlocksPerMultiprocessor(&per_cu, (const void*)fwd_megakernel, 512, LDS_BYTES);
        (void)hipGetLastError();
        if (per_cu < 1) fprintf(stderr, "kernel_launch: occupancy query says %d blocks per CU\n", per_cu);
        grid = cus;
        if (grid != 256) { fprintf(stderr, "kernel_launch: this kernel's tile assignment is built for 256 CUs, found %d; launching 256 workgroups anyway\n", cus); grid = 256; }
    }
    if (grid < 0) return;
    Params p{};
    p.x = (const float*)d_in[0]; p.mem = (const float*)d_in[1]; p.pos = (const int*)d_in[2];
    p.ffn1_norm = (const float*)d_in[3]; p.ffn1_w1 = (const float*)d_in[4]; p.ffn1_w3 = (const float*)d_in[5]; p.ffn1_w2 = (const float*)d_in[6];
    p.mix_norm = (const float*)d_in[7]; p.w_in = (const float*)d_in[8]; p.conv_w = (const float*)d_in[9]; p.conv_b = (const float*)d_in[10];
    p.conv_ln_g = (const float*)d_in[11]; p.conv_ln_b = (const float*)d_in[12]; p.swa_q_norm = (const float*)d_in[13]; p.swa_k_norm = (const float*)d_in[14];
    p.swa_sinks = (const float*)d_in[15]; p.mem_norm = (const float*)d_in[16]; p.w_mem_kv = (const float*)d_in[17]; p.mem_q_norm = (const float*)d_in[18];
    p.mem_k_norm = (const float*)d_in[19]; p.w_out = (const float*)d_in[20]; p.ffn2_norm = (const float*)d_in[21]; p.ffn2_w1 = (const float*)d_in[22];
    p.ffn2_w3 = (const float*)d_in[23]; p.ffn2_w2 = (const float*)d_in[24]; p.final_norm = (const float*)d_in[25];
    p.out = (float*)d_out; p.ws = (unsigned char*)d_ws;
    if (hipMemsetAsync((char*)d_ws + WS_CTL, 0, CTL_ZERO_BYTES, stream) != hipSuccess) { fprintf(stderr, "kernel_launch: memset failed\n"); return; }
    void* args[] = {&p};
    hipError_t e = hipLaunchCooperativeKernel((const void*)fwd_megakernel, dim3(grid), dim3(512), args, LDS_BYTES, stream);
    if (e != hipSuccess) fprintf(stderr, "kernel_launch: cooperative launch failed: %s (grid %d)\n", hipGetErrorString(e), grid);
}
```

```cpp
#include <hip/hip_runtime.h>
#include <hip/hip_cooperative_groups.h>
#include <cstdio>
#include <cstdint>
namespace cg = cooperative_groups;

#define LAS __attribute__((address_space(3)))
typedef unsigned short bf16_t;
typedef short bf16x8 __attribute__((ext_vector_type(8)));
typedef short s16x4 __attribute__((ext_vector_type(4)));
typedef float f32x4 __attribute__((ext_vector_type(4)));
typedef unsigned u32x4 __attribute__((ext_vector_type(4)));
typedef unsigned u32x2 __attribute__((ext_vector_type(2)));
typedef float f32x2 __attribute__((ext_vector_type(2)));

constexpr int DM = 1024, BATCH = 2, SEQ = 8192, DEPTH = 4, MEMLEN = 256, HD = 64;
constexpr int M = BATCH * SEQ;
constexpr int CONVC = 384, CONVW = 31;
constexpr int DIN = 1664, DINP = 1792;
constexpr int DFF = 2816;
constexpr int MROWS = BATCH * MEMLEN;
constexpr float EPS = 1e-6f;
constexpr int PC_A = 0, PC_G = 384, PC_Q = 768, PC_K = 1152, PC_V = 1280, PC_QM = 1408;
constexpr int YC_CONV = 0, YC_SWA = 384, YC_MEM = 768;

constexpr size_t MiB = 1u << 20;
constexpr size_t WS_PA = 0 * MiB, WS_PB = 1 * MiB, WS_PC = 2 * MiB;
constexpr size_t WS_XBUF = 3 * MiB + 256 * 1024;
constexpr int CW_PANEL = 8192;
constexpr size_t WS_PM = 3 * MiB;
constexpr size_t WS_COS = 4 * MiB, WS_SIN = 6 * MiB;
constexpr size_t WS_MEMB = 8 * MiB;
constexpr size_t WS_MKV = 9 * MiB;
constexpr size_t WS_CTL = 12 * MiB, CTL_ZERO_BYTES = 65536;
constexpr size_t WS_W = 16 * MiB;
constexpr size_t SZ_W13 = (size_t)2 * DFF * DM * 2, SZ_W2 = (size_t)DM * DFF * 2, SZ_WIN = (size_t)DINP * DM * 2, SZ_WOUT = (size_t)DM * DM * 2;
constexpr size_t OFF_W13A = 0, OFF_W2A = OFF_W13A + SZ_W13, OFF_WIN = OFF_W2A + SZ_W2, OFF_WOUT = OFF_WIN + SZ_WIN, OFF_W13B = OFF_WOUT + SZ_WOUT, OFF_W2B = OFF_W13B + SZ_W13;
constexpr size_t SZ_LAYER = OFF_W2B + SZ_W2;
constexpr size_t WS_WM = WS_W + 4 * SZ_LAYER;
constexpr size_t WS_RB = 176 * MiB;
constexpr size_t WS_FF = 208 * MiB;
constexpr size_t WS_P = WS_FF, WS_Y = WS_FF + 56 * MiB;
constexpr size_t WS_END = 296 * MiB;
static_assert(WS_WM + (size_t)2048 * 1024 * 2 <= WS_RB, "ws map");
static_assert(SZ_LAYER == (size_t)77 * MiB / 2, "layer weights 38.5 MiB");

constexpr int LDS_BYTES = 147456;
constexpr int LDS_RS_OFF = 131072 + 64;
constexpr int LDS_MISC = 131072;

__device__ __forceinline__ unsigned cvt_pk_bf16(float lo, float hi) { unsigned r; asm volatile("v_cvt_pk_bf16_f32 %0, %1, %2" : "=v"(r) : "v"(lo), "v"(hi)); return r; }
__device__ __forceinline__ float bf2f(short s) { return __uint_as_float(((unsigned)(unsigned short)s) << 16); }
__device__ __forceinline__ float wave_sum(float v) {
#pragma unroll
    for (int o = 1; o < 64; o <<= 1) v += __shfl_xor(v, o);
    return v;
}
__device__ __forceinline__ float fast_rcp(float x) { return __builtin_amdgcn_rcpf(x); }
__device__ __forceinline__ float silu_f(float x) { return x * fast_rcp(1.0f + __builtin_amdgcn_exp2f(-1.4426950408889634f * x)); }
__device__ __forceinline__ float sigmoid_f(float x) { return fast_rcp(1.0f + __builtin_amdgcn_exp2f(-1.4426950408889634f * x)); }

__device__ __forceinline__ int opaque_tid() { int t = threadIdx.x; asm volatile("" : "+v"(t)); return t; }
__device__ __forceinline__ unsigned opaque_zero() { unsigned z = 0u; asm volatile("" : "+v"(z)); return z; }
__device__ __forceinline__ int opaque_bid() { int t = blockIdx.x; asm volatile("" : "+s"(t)); return t; }
template <class T> __device__ __forceinline__ T* opaque_ptr(T* q) { asm volatile("" : "+s"(q)); return q; }

__device__ __forceinline__ unsigned xb_ld(unsigned* p);
__device__ __forceinline__ unsigned xb_add(unsigned* p, unsigned v);
#ifndef PG8_SP2_DEFAULT
#define PG8_SP2_DEFAULT true
#endif
namespace pg8 {
constexpr int BM = 256, BK = 64, HALF = 128, HTB = HALF * BK * 2, STAGE_BYTES = 8 * HTB, NXCD = 8, WGM = 8;
__host__ __device__ __forceinline__ int lds_byte(int r, int c) { const int st = (r >> 4) * 2 + (c >> 5), rr = r & 15, cc = c & 31, ob = rr * 64 + cc * 2; return st * 1024 + (ob ^ (((ob >> 9) & 1) << 5)); }
__host__ __device__ __forceinline__ void stage_rc(int b, int& R, int& C) { const int st = b / 1024, sb = b % 1024, swz = sb ^ (((sb >> 9) & 1) << 5); R = (st >> 1) * 16 + swz / 64; C = (st & 1) * 32 + (swz % 64) / 2; }
__host__ __device__ __forceinline__ int perm32(int rho) { const int n = rho >> 4, i = rho & 15; return 8 * (i >> 2) + 4 * n + (i & 3); }

struct Unit { int pm, pn; };
struct Gemm { const bf16_t* A; const bf16_t* Bt; int M, N, K; };

struct StaticOrder {
    int nM, nN, nwg, G, c;
    __device__ void init(int M_, int N_, int G_, int c_) { nM = M_ / BM; nN = N_ / BM; nwg = nM * nN; G = G_; c = c_; }
    __device__ bool next(int i, Unit& u) const {
        const long L = (long)i * G + c; if (L >= nwg) return false;
        int wgid = (int)L; { const int q = nwg / NXCD, r = nwg % NXCD, xcd = wgid % NXCD, off = wgid / NXCD; wgid = (xcd < r ? xcd * (q + 1) : r * (q + 1) + (xcd - r) * q) + off; }
        const int nig = WGM * nN, gid = wgid / nig, fm = gid * WGM, gsz = (nM - fm) < WGM ? (nM - fm) : WGM;
        u.pm = fm + ((wgid % nig) % gsz); u.pn = (wgid % nig) / gsz; return true;
    }
};

struct PanelOrder {
    int nN, pm, k;
    __device__ void init(int N_, int c_) { nN = N_ / BM; const int j = c_ >> 3; pm = 8 * (c_ & 7) + (j & 7); k = j >> 3; }
    __device__ bool next(int i, Unit& u) const { const int pn = k + 4 * i; if (pn >= nN) return false; u.pm = pm; u.pn = pn; return true; }
};


struct RowScaleSpec { const float* PA; const float* PB; int useA, withB; };
__device__ __forceinline__ void read_row_scales(LAS const float* rst, int wr, int fr, float (&rs)[2][4]) {
#pragma unroll
    for (int ai = 0; ai < 2; ++ai)
#pragma unroll
        for (int m = 0; m < 4; ++m) rs[ai][m] = rst[ai * HALF + wr * 64 + m * 16 + fr];
}

struct EpiSwiglu {
    static constexpr bool PERM = true;
    bf16_t* O; RowScaleSpec rsp;
    __device__ __forceinline__ void operator()(const f32x4 (&acc)[2][2][4][2], const Unit& u, int wr, int wc, int fr, int fq, LAS const float* rst) const {
        asm volatile("" : "+v"(fr), "+v"(fq));
        const int row0 = u.pm * BM + wr * 64 + fr, col0 = u.pn * HALF + wc * 32 + 8 * fq;
        float rs[2][4];
        read_row_scales(rst, wr, fr, rs);
#pragma unroll
        for (int ai = 0; ai < 2; ++ai)
#pragma unroll
            for (int m = 0; m < 4; ++m) {
                const float r = rs[ai][m], nr = -1.4426950408889634f * r, r2 = r * r;
                float o[8];
#pragma unroll
                for (int n = 0; n < 2; ++n)
#pragma unroll
                    for (int jp = 0; jp < 2; ++jp) {
                        const f32x2 a = {acc[ai][0][m][n][2 * jp], acc[ai][0][m][n][2 * jp + 1]}, b = {acc[ai][1][m][n][2 * jp], acc[ai][1][m][n][2 * jp + 1]};
                        const f32x2 t = a * nr; f32x2 e; e.x = __builtin_amdgcn_exp2f(t.x); e.y = __builtin_amdgcn_exp2f(t.y);
                        const f32x2 d = e + 1.0f; f32x2 q; q.x = __builtin_amdgcn_rcpf(d.x); q.y = __builtin_amdgcn_rcpf(d.y);
                        const f32x2 ov = (a * b) * (q * r2);
                        o[4 * n + 2 * jp] = ov.x; o[4 * n + 2 * jp + 1] = ov.y;
                    }
                u32x4 w; w.x = cvt_pk_bf16(o[0], o[1]); w.y = cvt_pk_bf16(o[2], o[3]); w.z = cvt_pk_bf16(o[4], o[5]); w.w = cvt_pk_bf16(o[6], o[7]);
                *(u32x4*)(O + (size_t)(row0 + ai * HALF + m * 16) * DFF + col0) = w;
            }
    }
};
struct EpiProj {
    static constexpr bool PERM = true;
    bf16_t* O; int ldc; RowScaleSpec rsp;
    __device__ __forceinline__ void operator()(const f32x4 (&acc)[2][2][4][2], const Unit& u, int wr, int wc, int fr, int fq, LAS const float* rst) const {
        asm volatile("" : "+v"(fr), "+v"(fq));
        const int row0 = u.pm * BM + wr * 64 + fr, col0 = u.pn * BM + wc * 32 + 8 * fq;
        float rs[2][4];
        read_row_scales(rst, wr, fr, rs);
#pragma unroll
        for (int ai = 0; ai < 2; ++ai)
#pragma unroll
            for (int m = 0; m < 4; ++m) {
                const float r = rs[ai][m];
#pragma unroll
                for (int bj = 0; bj < 2; ++bj) {
                    const f32x4 v0 = acc[ai][bj][m][0] * r, v1 = acc[ai][bj][m][1] * r;
                    u32x4 w; w.x = cvt_pk_bf16(v0[0], v0[1]); w.y = cvt_pk_bf16(v0[2], v0[3]); w.z = cvt_pk_bf16(v1[0], v1[1]); w.w = cvt_pk_bf16(v1[2], v1[3]);
                    *(u32x4*)(O + (size_t)(row0 + ai * HALF + m * 16) * ldc + col0 + bj * HALF) = w;
                }
            }
    }
};
struct EpiResid {
    static constexpr bool PERM = true;
    bf16_t* ob; RowScaleSpec rsp; float alpha; const float* gf; float* P1; float* P2;
    __device__ __forceinline__ void operator()(const f32x4 (&acc)[2][2][4][2], const Unit& u, int wr, int wc, int fr, int fq, LAS const float* rst) const {
        asm volatile("" : "+v"(fr), "+v"(fq));
        const int row0 = u.pm * BM + wr * 64 + fr, col0 = u.pn * BM + wc * 32 + 8 * fq;
        float r3[2][4];
        read_row_scales(rst, wr, fr, r3);
        f32x4 g[2][2];
#pragma unroll
        for (int bj = 0; bj < 2; ++bj)
#pragma unroll
            for (int n = 0; n < 2; ++n) g[bj][n] = gf ? *(const f32x4*)(gf + col0 + bj * HALF + 4 * n) : (f32x4){1.f, 1.f, 1.f, 1.f};
#pragma unroll
        for (int ai = 0; ai < 2; ++ai) {
            bf16x8 rb[4][2];
#pragma unroll
            for (int m = 0; m < 4; ++m)
#pragma unroll
                for (int bj = 0; bj < 2; ++bj) rb[m][bj] = *(const bf16x8*)(ob + (size_t)(row0 + ai * HALF + m * 16) * DM + col0 + bj * HALF);
#pragma unroll
            for (int m = 0; m < 4; ++m) {
                const int row = row0 + ai * HALF + m * 16; const size_t off = (size_t)row * DM + col0;
                float s1 = 0.f, s2 = 0.f;
#pragma unroll
                for (int bj = 0; bj < 2; ++bj) {
                    const bf16x8 t = rb[m][bj];
                    const f32x4 i0 = (f32x4){bf2f(t[0]), bf2f(t[1]), bf2f(t[2]), bf2f(t[3])}, i1 = (f32x4){bf2f(t[4]), bf2f(t[5]), bf2f(t[6]), bf2f(t[7])};
                    const f32x4 h0 = i0 * r3[ai][m] + acc[ai][bj][m][0] * alpha, h1 = i1 * r3[ai][m] + acc[ai][bj][m][1] * alpha;
                    s1 += (h0[0] * h0[0] + h0[1] * h0[1]) + (h0[2] * h0[2] + h0[3] * h0[3]) + (h1[0] * h1[0] + h1[1] * h1[1]) + (h1[2] * h1[2] + h1[3] * h1[3]);
                    const f32x4 z0 = h0 * g[bj][0], z1 = h1 * g[bj][1];
                    s2 += (z0[0] * z0[0] + z0[1] * z0[1]) + (z0[2] * z0[2] + z0[3] * z0[3]) + (z1[0] * z1[0] + z1[1] * z1[1]) + (z1[2] * z1[2] + z1[3] * z1[3]);
                    u32x4 w; w.x = cvt_pk_bf16(z0[0], z0[1]); w.y = cvt_pk_bf16(z0[2], z0[3]); w.z = cvt_pk_bf16(z1[0], z1[1]); w.w = cvt_pk_bf16(z1[2], z1[3]);
                    *(u32x4*)(ob + off + bj * HALF) = w;
                }
                s1 += __shfl_xor(s1, 16); s1 += __shfl_xor(s1, 32);
                s2 += __shfl_xor(s2, 16); s2 += __shfl_xor(s2, 32);
                if (fq == 0) { P1[(size_t)row * 16 + u.pn * 4 + wc] = s1; if (P2) P2[(size_t)row * 16 + u.pn * 4 + wc] = s2; }
            }
        }
    }
};

struct EpiFinal {
    static constexpr bool PERM = true;
    const bf16_t* rbuf; RowScaleSpec rsp; float alpha; const float* gf; float* out; float* xbuf; unsigned* cnt;
    __device__ __forceinline__ void operator()(f32x4 (&acc)[2][2][4][2], const Unit& u, int wr, int wc, int fr, int fq, LAS const float* rst) const {
        asm volatile("" : "+v"(fr), "+v"(fq));
        LAS float* tab = (LAS float*)((LAS unsigned char*)rst + 1024);
        LAS float* r3t = (LAS float*)((LAS unsigned char*)rst + 1024 + 4096);
        const int tid = opaque_tid();
        const int row0 = u.pm * BM + wr * 64 + fr, col0 = u.pn * BM + wc * 32 + 8 * fq;
        f32x4 g[2][2];
#pragma unroll
        for (int bj = 0; bj < 2; ++bj)
#pragma unroll
            for (int n = 0; n < 2; ++n) g[bj][n] = *(const f32x4*)(gf + col0 + bj * HALF + 4 * n);
#pragma unroll
        for (int ai = 0; ai < 2; ++ai) {
            bf16x8 rb[4][2];
#pragma unroll
            for (int m = 0; m < 4; ++m)
#pragma unroll
                for (int bj = 0; bj < 2; ++bj) rb[m][bj] = *(const bf16x8*)(rbuf + (size_t)(row0 + ai * HALF + m * 16) * DM + col0 + bj * HALF);
#pragma unroll
            for (int m = 0; m < 4; ++m) {
                float s1 = 0.f;
#pragma unroll
                for (int bj = 0; bj < 2; ++bj) {
                    const bf16x8 t = rb[m][bj];
                    const f32x4 i0 = (f32x4){bf2f(t[0]), bf2f(t[1]), bf2f(t[2]), bf2f(t[3])}, i1 = (f32x4){bf2f(t[4]), bf2f(t[5]), bf2f(t[6]), bf2f(t[7])};
                    const f32x4 h0 = i0 + acc[ai][bj][m][0] * alpha, h1 = i1 + acc[ai][bj][m][1] * alpha;
                    s1 += (h0[0] * h0[0] + h0[1] * h0[1]) + (h0[2] * h0[2] + h0[3] * h0[3]) + (h1[0] * h1[0] + h1[1] * h1[1]) + (h1[2] * h1[2] + h1[3] * h1[3]);
                    acc[ai][bj][m][0] = h0 * g[bj][0]; acc[ai][bj][m][1] = h1 * g[bj][1];
                }
                s1 += __shfl_xor(s1, 16); s1 += __shfl_xor(s1, 32);
                if (fq == 0) tab[(ai * HALF + wr * 64 + m * 16 + fr) * 4 + wc] = s1;
            }
        }
        asm volatile("s_waitcnt lgkmcnt(0)" ::: "memory"); __builtin_amdgcn_s_barrier(); asm volatile("" ::: "memory");
        if (tid < BM) {
            const float ts = (tab[tid * 4 + 0] + tab[tid * 4 + 1]) + (tab[tid * 4 + 2] + tab[tid * 4 + 3]);
            __hip_atomic_store(xbuf + (size_t)(u.pm * BM + tid) * 4 + u.pn, ts, __ATOMIC_RELAXED, __HIP_MEMORY_SCOPE_AGENT);
        }
        asm volatile("s_waitcnt vmcnt(0) lgkmcnt(0)" ::: "memory"); __builtin_amdgcn_s_barrier(); asm volatile("" ::: "memory");
        if (tid == 0) {
            unsigned* c = cnt + 64 * u.pm;
            (void)xb_add(c, 1u);
            unsigned sp = 0;
            while (xb_ld(c) < 4u) { __builtin_amdgcn_s_sleep(1); if (++sp > (1u << 22)) break; }
            __builtin_amdgcn_fence(__ATOMIC_ACQUIRE, "agent");
            asm volatile("s_waitcnt vmcnt(0)" ::: "memory");
        }
        asm volatile("s_waitcnt lgkmcnt(0)" ::: "memory"); __builtin_amdgcn_s_barrier(); asm volatile("" ::: "memory");
        if (tid < BM) {
            const float* xr = xbuf + (size_t)(u.pm * BM + tid) * 4;
            const float t0 = __hip_atomic_load(xr + 0, __ATOMIC_RELAXED, __HIP_MEMORY_SCOPE_AGENT), t1 = __hip_atomic_load(xr + 1, __ATOMIC_RELAXED, __HIP_MEMORY_SCOPE_AGENT);
            const float t2 = __hip_atomic_load(xr + 2, __ATOMIC_RELAXED, __HIP_MEMORY_SCOPE_AGENT), t3 = __hip_atomic_load(xr + 3, __ATOMIC_RELAXED, __HIP_MEMORY_SCOPE_AGENT);
            r3t[tid] = __builtin_amdgcn_rsqf(((t0 + t1) + (t2 + t3)) * (1.0f / DM) + EPS);
        }
        asm volatile("s_waitcnt vmcnt(0) lgkmcnt(0)" ::: "memory"); __builtin_amdgcn_s_barrier(); asm volatile("" ::: "memory");
#pragma unroll
        for (int ai = 0; ai < 2; ++ai)
#pragma unroll
            for (int m = 0; m < 4; ++m) {
                const float r3 = r3t[ai * HALF + wr * 64 + m * 16 + fr];
                float* orow = out + (size_t)(row0 + ai * HALF + m * 16) * DM + col0;
#pragma unroll
                for (int bj = 0; bj < 2; ++bj) { *(f32x4*)(orow + bj * HALF) = acc[ai][bj][m][0] * r3; *(f32x4*)(orow + bj * HALF + 4) = acc[ai][bj][m][1] * r3; }
            }
    }
};

template <class Epi, class Sched, bool ALIGN_EPI, bool SP2 = PG8_SP2_DEFAULT>
__device__ __forceinline__ void gemm_phase(LAS unsigned char* lds, const Gemm g, const Sched& S, const Epi& E) {
    const int tid = opaque_tid(), wid = __builtin_amdgcn_readfirstlane(tid >> 6), lane = tid & 63, wr = wid >> 2, wc = wid & 3, fr = lane & 15, fq = lane >> 4;
    const int K = g.K, nt = K / BK;
    unsigned voffA[2], voffB[2];
#pragma unroll
    for (int i = 0; i < 2; ++i) { int R, C; stage_rc(tid * 16 + i * 8192, R, C); const int Rb = Epi::PERM ? ((R & ~31) + perm32(R & 31)) : R;
        voffA[i] = (unsigned)(R * K + C) * 2u; voffB[i] = (unsigned)(Rb * K + C) * 2u; }
    const size_t kstep = (size_t)(BK * 2);
    const size_t hstep = (size_t)HALF * K * 2;
    const size_t tstep = 2 * hstep;
    const unsigned ldsw = (unsigned)wid * 1024u;
    const int aoff = lds_byte(wr * 64 + fr, fq * 8), boff = lds_byte(wc * 32 + fr, fq * 8);
#define PG8_SA(b, h) (((b) * 2 + (h)) * HTB)
#define PG8_SB(b, h) ((4 + (b) * 2 + (h)) * HTB)
#define PG8_STAGE(bufoff, gbase, voff) do { _Pragma("unroll") for (int _i = 0; _i < 2; ++_i) \
        __builtin_amdgcn_global_load_lds((const unsigned*)((const char*)(gbase) + (voff)[_i]), (LAS unsigned*)(lds + (bufoff) + ldsw + _i * 8192), 16, 0, 0); } while (0)
#define PG8_LDA(dst, b, h) do { _Pragma("unroll") for (int m = 0; m < 4; ++m) _Pragma("unroll") for (int k = 0; k < 2; ++k) dst[m][k] = *(const LAS bf16x8*)(lds + PG8_SA(b, h) + aoff + m * 2048 + k * 1024); } while (0)
#define PG8_LDB(dst, b, h) do { _Pragma("unroll") for (int n = 0; n < 2; ++n) _Pragma("unroll") for (int k = 0; k < 2; ++k) dst[n][k] = *(const LAS bf16x8*)(lds + PG8_SB(b, h) + boff + n * 2048 + k * 1024); } while (0)
#define PG8_MMA(ai, bj, At, Bt) do { __builtin_amdgcn_s_setprio(1); _Pragma("unroll") for (int m = 0; m < 4; ++m) _Pragma("unroll") for (int n = 0; n < 2; ++n) _Pragma("unroll") for (int k = 0; k < 2; ++k) \
        acc[ai][bj][m][n] = __builtin_amdgcn_mfma_f32_16x16x32_bf16(Bt[n][k], At[m][k], acc[ai][bj][m][n], 0, 0, 0); __builtin_amdgcn_s_setprio(0); } while (0)
#define PG8_WAIT_V(n) asm volatile("s_waitcnt vmcnt(" #n ")" ::: "memory")
#define PG8_WAIT_L(n) asm volatile("s_waitcnt lgkmcnt(" #n ")" ::: "memory")
#define PG8_BAR __builtin_amdgcn_s_barrier()
#define PG8_SCHED __builtin_amdgcn_sched_barrier(0)
    Unit cur, nxt; int ui = 0;
    if (!S.next(0, cur)) return;
    f32x4 acc[2][2][4][2];
#pragma unroll
    for (int a = 0; a < 2; ++a)
#pragma unroll
        for (int b = 0; b < 2; ++b)
#pragma unroll
            for (int m = 0; m < 4; ++m)
#pragma unroll
                for (int n = 0; n < 2; ++n) acc[a][b][m][n] = (f32x4){0.f, 0.f, 0.f, 0.f};
    bf16x8 At[4][2], B0[2][2], B1[2][2];
    const char* cA = (const char*)g.A + (size_t)cur.pm * tstep; const char* cB = (const char*)g.Bt + (size_t)cur.pn * tstep;
    LAS float* rst = (LAS float*)(lds + LDS_RS_OFF);
    const RowScaleSpec rsp = E.rsp; const bool rs_ld = (rsp.useA | rsp.withB) != 0;
    f32x4 pa0 = {0.f, 0.f, 0.f, 0.f}, pa1 = pa0, pb0 = pa0, pb1 = pa0;
    if (rs_ld) { const size_t o = (size_t)(cur.pm * BM + (tid >> 1)) * 16 + (tid & 1) * 8;
        pa0 = *(const f32x4*)(rsp.PA + o); pa1 = *(const f32x4*)(rsp.PA + o + 4);
        if (rsp.withB) { pb0 = *(const f32x4*)(rsp.PB + o); pb1 = *(const f32x4*)(rsp.PB + o + 4); } }
    if constexpr (SP2) { PG8_STAGE(PG8_SB(0, 0), cB, voffB); PG8_STAGE(PG8_SB(0, 1), cB + hstep, voffB); PG8_STAGE(PG8_SA(0, 0), cA, voffA); PG8_STAGE(PG8_SA(0, 1), cA + hstep, voffA); }
    else { PG8_STAGE(PG8_SB(0, 0), cB, voffB); PG8_STAGE(PG8_SA(0, 0), cA, voffA); PG8_STAGE(PG8_SB(0, 1), cB + hstep, voffB); PG8_STAGE(PG8_SA(0, 1), cA + hstep, voffA); }
    {
        float sa = ((pa0[0] + pa0[1]) + (pa0[2] + pa0[3])) + ((pa1[0] + pa1[1]) + (pa1[2] + pa1[3])); sa += __shfl_xor(sa, 1);
        float sb = ((pb0[0] + pb0[1]) + (pb0[2] + pb0[3])) + ((pb1[0] + pb1[1]) + (pb1[2] + pb1[3])); sb += __shfl_xor(sb, 1);
        float r = rsp.useA ? __builtin_amdgcn_rsqf(sa * (1.0f / DM) + EPS) : 1.0f;
        if (rsp.withB) r = r * __builtin_amdgcn_rsqf(r * r * sb * (1.0f / DM) + EPS);
        if ((tid & 1) == 0) rst[tid >> 1] = r;
    }
    if (wr == 1) PG8_BAR;
    if constexpr (SP2) { PG8_WAIT_V(2); } else { PG8_WAIT_V(4); } PG8_BAR;
    PG8_STAGE(PG8_SB(1, 0), cB + kstep, voffB); PG8_STAGE(PG8_SA(1, 0), cA + kstep, voffA); PG8_STAGE(PG8_SB(1, 1), cB + hstep + kstep, voffB);
    PG8_WAIT_V(6); PG8_BAR;
    for (;;) {
        const bool has_next = S.next(ui + 1, nxt);
        const char* nA = has_next ? (const char*)g.A + (size_t)nxt.pm * tstep : cA; const char* nB = has_next ? (const char*)g.Bt + (size_t)nxt.pn * tstep : cB;
        for (int t = 0; t < nt; t += 2) {
            const bool last = (t == nt - 2);
            const char* a1 = cA + (size_t)(t + 1) * kstep;
            const char* a2 = last ? nA : cA + (size_t)(t + 2) * kstep; const char* b2 = last ? nB : cB + (size_t)(t + 2) * kstep;
            const char* a3 = a2 + kstep; const char* b3 = b2 + kstep;
            if constexpr (SP2) {
            PG8_LDB(B0, 0, 0); PG8_LDB(B1, 0, 1); PG8_SCHED; PG8_LDA(At, 0, 0); PG8_STAGE(PG8_SA(1, 1), a1 + hstep, voffA);
            PG8_WAIT_V(8); PG8_WAIT_L(0); PG8_BAR; PG8_MMA(0, 0, At, B0); PG8_MMA(0, 1, At, B1); PG8_BAR; PG8_SCHED;
            PG8_LDA(At, 0, 1); PG8_STAGE(PG8_SB(0, 0), b2, voffB); PG8_STAGE(PG8_SB(0, 1), b2 + hstep, voffB); PG8_STAGE(PG8_SA(0, 0), a2, voffA);
            PG8_WAIT_V(8); PG8_WAIT_L(0); PG8_BAR; PG8_MMA(1, 0, At, B0); PG8_MMA(1, 1, At, B1); PG8_BAR; PG8_SCHED;
            PG8_LDB(B0, 1, 0); PG8_LDB(B1, 1, 1); PG8_SCHED; PG8_LDA(At, 1, 0); PG8_STAGE(PG8_SA(0, 1), a2 + hstep, voffA);
            PG8_WAIT_V(8); PG8_WAIT_L(0); PG8_BAR; PG8_MMA(0, 0, At, B0); PG8_MMA(0, 1, At, B1); PG8_BAR; PG8_SCHED;
            PG8_LDA(At, 1, 1); PG8_STAGE(PG8_SB(1, 0), b3, voffB); PG8_STAGE(PG8_SB(1, 1), b3 + hstep, voffB); PG8_STAGE(PG8_SA(1, 0), a3, voffA);
            PG8_WAIT_V(8); PG8_WAIT_L(0); PG8_BAR; PG8_MMA(1, 0, At, B0); PG8_MMA(1, 1, At, B1); PG8_BAR; PG8_SCHED;
            } else {
            PG8_LDB(B0, 0, 0); PG8_SCHED; PG8_LDA(At, 0, 0); PG8_STAGE(PG8_SA(1, 1), a1 + hstep, voffA);
            PG8_WAIT_L(8); PG8_BAR; PG8_WAIT_L(0); PG8_MMA(0, 0, At, B0); PG8_BAR; PG8_SCHED;
            PG8_LDB(B1, 0, 1); PG8_STAGE(PG8_SB(0, 0), b2, voffB);
            PG8_BAR; PG8_WAIT_L(0); PG8_MMA(0, 1, At, B1); PG8_BAR;
            PG8_LDA(At, 0, 1); PG8_STAGE(PG8_SA(0, 0), a2, voffA);
            PG8_BAR; PG8_WAIT_L(0); PG8_MMA(1, 0, At, B0); PG8_BAR; PG8_SCHED;
            PG8_STAGE(PG8_SB(0, 1), b2 + hstep, voffB);
            PG8_WAIT_V(6); PG8_BAR; PG8_MMA(1, 1, At, B1); PG8_BAR;
            PG8_LDB(B0, 1, 0); PG8_SCHED; PG8_LDA(At, 1, 0); PG8_STAGE(PG8_SA(0, 1), a2 + hstep, voffA);
            PG8_WAIT_L(8); PG8_BAR; PG8_WAIT_L(0); PG8_MMA(0, 0, At, B0); PG8_BAR; PG8_SCHED;
            PG8_LDB(B1, 1, 1); PG8_STAGE(PG8_SB(1, 0), b3, voffB);
            PG8_BAR; PG8_WAIT_L(0); PG8_MMA(0, 1, At, B1); PG8_BAR;
            PG8_LDA(At, 1, 1); PG8_STAGE(PG8_SA(1, 0), a3, voffA);
            PG8_BAR; PG8_WAIT_L(0); PG8_MMA(1, 0, At, B0); PG8_BAR; PG8_SCHED;
            PG8_STAGE(PG8_SB(1, 1), b3 + hstep, voffB);
            PG8_WAIT_V(6); PG8_BAR; PG8_MMA(1, 1, At, B1); PG8_BAR;
            }
        }
        if constexpr (ALIGN_EPI) { if (wr == 0) PG8_BAR; }
        E(acc, cur, wr, wc, fr, fq, rst);
        if (!has_next) break;
        if (nxt.pm != cur.pm) __builtin_trap();
#pragma unroll
        for (int a = 0; a < 2; ++a)
#pragma unroll
            for (int b = 0; b < 2; ++b)
#pragma unroll
                for (int m = 0; m < 4; ++m)
#pragma unroll
                    for (int n = 0; n < 2; ++n) acc[a][b][m][n] = (f32x4){0.f, 0.f, 0.f, 0.f};
        cur = nxt; cA = nA; cB = nB; ++ui;
        if constexpr (ALIGN_EPI) { if (wr == 1) PG8_BAR; }
    }
    PG8_WAIT_V(0);
    if constexpr (!ALIGN_EPI) { if (wr == 0) PG8_BAR; }
    PG8_BAR;
#undef PG8_SA
#undef PG8_SB
#undef PG8_STAGE
#undef PG8_LDA
#undef PG8_LDB
#undef PG8_MMA
#undef PG8_WAIT_V
#undef PG8_WAIT_L
#undef PG8_BAR
#undef PG8_SCHED
}
}

struct Params {
    const float* x; const float* mem; const int* pos;
    const float* ffn1_norm; const float* ffn1_w1; const float* ffn1_w3; const float* ffn1_w2;
    const float* mix_norm; const float* w_in; const float* conv_w; const float* conv_b; const float* conv_ln_g; const float* conv_ln_b;
    const float* swa_q_norm; const float* swa_k_norm; const float* swa_sinks;
    const float* mem_norm; const float* w_mem_kv; const float* mem_q_norm; const float* mem_k_norm; const float* w_out;
    const float* ffn2_norm; const float* ffn2_w1; const float* ffn2_w3; const float* ffn2_w2; const float* final_norm;
    float* out; unsigned char* ws;
};

typedef const __attribute__((address_space(4))) Params* KP;
__device__ __forceinline__ KP kparams() { KP q = (KP)__builtin_amdgcn_kernarg_segment_ptr(); asm volatile("" : "+s"(q)); return q; }

#define XB_TMO      128
#define XB_XCNT(j)  (256  + 64 * (j))
#define XB_XSUB(j)  (1280 + 64 * (j))
#define XB_XGEN(j)  (2304 + 64 * (j))
#define XB_TOP      3328
#define XB_TOPGEN   3392
#define XCD_BAR_WORDS 3456
#define XB_SPIN_CAP (1u << 20)
__device__ __forceinline__ unsigned xb_ld(unsigned* p)              { return __hip_atomic_load(p, __ATOMIC_RELAXED, __HIP_MEMORY_SCOPE_AGENT); }
__device__ __forceinline__ unsigned xb_add(unsigned* p, unsigned v) { return __hip_atomic_fetch_add(p, v, __ATOMIC_RELAXED, __HIP_MEMORY_SCOPE_AGENT); }
__device__ __forceinline__ unsigned xb_xcc_id() { return (unsigned)__builtin_amdgcn_s_getreg((3 << 11) | 20) & 0xFu; }
#define XB_SPIN(cond, bar) do { unsigned _sp = 0; while (cond) { __builtin_amdgcn_s_sleep(1); \
    if ((++_sp & 255u) == 0u) { if (xb_ld(&(bar)[XB_TMO])) break; if (_sp > XB_SPIN_CAP) { atomicAdd(&(bar)[XB_TMO], 1u); break; } } } } while (0)
__device__ __forceinline__ void xcd_barrier_complete(unsigned* bar, unsigned x, unsigned& nloc, unsigned& nx) {
    const unsigned G = gridDim.x * gridDim.y * gridDim.z;
    unsigned sum, cnt, mine, sp = 0u;
    for (;;) {
        sum = 0u; cnt = 0u; mine = 0u;
#pragma unroll
        for (unsigned j = 0; j < 16; ++j) { const unsigned c = xb_ld(&bar[XB_XCNT(j)]); sum += c; cnt += (c > 0u) ? 1u : 0u; mine = (j == x) ? c : mine; }
        if (sum == G) break;
        __builtin_amdgcn_s_sleep(1);
        if ((++sp & 255u) == 0u) { if (xb_ld(&bar[XB_TMO])) break; if (sp > XB_SPIN_CAP) { atomicAdd(&bar[XB_TMO], 1u); break; } }
    }
    nloc = mine > 0u ? mine : 1u; nx = cnt > 0u ? cnt : 1u;
}
__device__ __forceinline__ void xcd_barrier(LAS unsigned char* lds) {
    asm volatile("s_waitcnt vmcnt(0)" ::: "memory");
    __syncthreads();
    if (opaque_tid() == 0) {
        unsigned* bar = (unsigned*)(kparams()->ws + WS_CTL);
        volatile LAS unsigned* st = (volatile LAS unsigned*)(lds + LDS_MISC);
        const unsigned x = xb_xcc_id();
        __builtin_amdgcn_s_waitcnt(0);
        unsigned nloc = st[0], nx = st[1];
        if (nloc == 0u) { xcd_barrier_complete(bar, x, nloc, nx); st[0] = nloc; st[1] = nx; }
        const unsigned old = xb_add(&bar[XB_XSUB(x)], 1u);
        const unsigned gen = old / nloc;
        if (old + 1u == (gen + 1u) * nloc) {
            __builtin_amdgcn_fence(__ATOMIC_RELEASE, "agent");
            asm volatile("s_waitcnt vmcnt(0)" ::: "memory");
            const unsigned og = xb_add(&bar[XB_TOP], 1u);
            const unsigned tg = og / nx;
            __builtin_amdgcn_fence(__ATOMIC_ACQUIRE, "agent");
            if (og + 1u == (tg + 1u) * nx) xb_add(&bar[XB_TOPGEN], 1u);
            else XB_SPIN(xb_ld(&bar[XB_TOPGEN]) == tg, bar);
            xb_add(&bar[XB_XGEN(x)], 1u);
            asm volatile("s_waitcnt vmcnt(0)" ::: "memory");
        } else {
            __builtin_amdgcn_fence(__ATOMIC_ACQUIRE, "agent");
            XB_SPIN(xb_ld(&bar[XB_XGEN(x)]) == gen, bar);
            asm volatile("s_waitcnt vmcnt(0)" ::: "memory");
        }
    }
    __syncthreads();
}

constexpr int TR_L_ITEMS = 704 * 6 + 416 + 256 + 128, TR_ITEMS = DEPTH * TR_L_ITEMS;
struct TrDesc { const float* W; bf16_t* WT; const float* gain; int K, N, il, row_off, item; };
constexpr int TR_L_MAIN = TR_L_ITEMS - 128;
__device__ __forceinline__ TrDesc tr_desc(KP pp, int l, int r) {
    unsigned char* ws = pp->ws; unsigned char* wl = ws + WS_W + (size_t)l * SZ_LAYER;
    const size_t o13 = (size_t)l * DM * DFF;
    TrDesc d;
    if (r < 704) { d = TrDesc{pp->ffn1_w1 + o13, (bf16_t*)(wl + OFF_W13A), pp->ffn1_norm + l * DM, DM, DFF, 1, 0, r}; return d; } r -= 704;
    if (r < 704) { d = TrDesc{pp->ffn1_w3 + o13, (bf16_t*)(wl + OFF_W13A), pp->ffn1_norm + l * DM, DM, DFF, 1, 128, r}; return d; } r -= 704;
    if (r < 704) { d = TrDesc{pp->ffn1_w2 + o13, (bf16_t*)(wl + OFF_W2A), nullptr, DFF, DM, 0, 0, r}; return d; } r -= 704;
    if (r < 416) { d = TrDesc{pp->w_in + (size_t)l * DM * DIN, (bf16_t*)(wl + OFF_WIN), pp->mix_norm + l * DM, DM, DIN, 0, 0, r}; return d; } r -= 416;
    if (r < 256) { d = TrDesc{pp->w_out + (size_t)l * DM * DM, (bf16_t*)(wl + OFF_WOUT), nullptr, DM, DM, 0, 0, r}; return d; } r -= 256;
    if (r < 704) { d = TrDesc{pp->ffn2_w1 + o13, (bf16_t*)(wl + OFF_W13B), pp->ffn2_norm + l * DM, DM, DFF, 1, 0, r}; return d; } r -= 704;
    if (r < 704) { d = TrDesc{pp->ffn2_w3 + o13, (bf16_t*)(wl + OFF_W13B), pp->ffn2_norm + l * DM, DM, DFF, 1, 128, r}; return d; } r -= 704;
    if (r < 704) { d = TrDesc{pp->ffn2_w2 + o13, (bf16_t*)(wl + OFF_W2B), nullptr, DFF, DM, 0, 0, r}; return d; } r -= 704;
    d = TrDesc{pp->w_mem_kv + (size_t)l * DM * 512, (bf16_t*)(ws + WS_WM), pp->mem_norm + l * DM, DM, 512, 0, l * 512, r}; return d;
}
__device__ __forceinline__ void tr_load(const TrDesc& d, int lane, f32x4 (&v)[16]) {
    const int nblk = d.N >> 6, kb = d.item / nblk, nb = d.item - kb * nblk;
    const float* src = d.W + (size_t)(64 * kb + 16 * (lane >> 4)) * d.N + 64 * nb + 4 * (lane & 15);
#pragma unroll
    for (int i = 0; i < 16; ++i) v[i] = __builtin_nontemporal_load((const f32x4*)(src + (size_t)i * d.N));
}
__device__ __forceinline__ void tr_store(const TrDesc& d, int lane, f32x4 (&v)[16]) {
    const int nblk = d.N >> 6, kb = d.item / nblk, nb = d.item - kb * nblk, kk = 64 * kb + 16 * (lane >> 4), nn = 64 * nb + 4 * (lane & 15);
    if (d.gain) {
#pragma unroll
        for (int q = 0; q < 4; ++q) { const f32x4 gq = *(const f32x4*)(d.gain + kk + 4 * q);
#pragma unroll
            for (int e = 0; e < 4; ++e) v[4 * q + e] = v[4 * q + e] * gq[e]; }
    }
#pragma unroll
    for (int j = 0; j < 4; ++j) {
        const int n = nn + j, drow = d.row_off + (d.il ? (((n >> 7) << 8) + (n & 127)) : n);
        u32x4 a, b;
        a.x = cvt_pk_bf16(v[0][j], v[1][j]); a.y = cvt_pk_bf16(v[2][j], v[3][j]); a.z = cvt_pk_bf16(v[4][j], v[5][j]); a.w = cvt_pk_bf16(v[6][j], v[7][j]);
        b.x = cvt_pk_bf16(v[8][j], v[9][j]); b.y = cvt_pk_bf16(v[10][j], v[11][j]); b.z = cvt_pk_bf16(v[12][j], v[13][j]); b.w = cvt_pk_bf16(v[14][j], v[15][j]);
        u32x4* o = (u32x4*)(d.WT + (size_t)drow * d.K + kk);
        o[0] = a; o[1] = b;
    }
}
__device__ __forceinline__ float row_to_bf16(const float* xrow, bf16_t* orow, int lane) {
    const f32x4* xr = (const f32x4*)xrow + lane; float s = 0.f; f32x4 v[4];
#pragma unroll
    for (int j = 0; j < 4; ++j) { v[j] = xr[64 * j]; s += (v[j][0] * v[j][0] + v[j][1] * v[j][1]) + (v[j][2] * v[j][2] + v[j][3] * v[j][3]); }
    u32x2* o8 = (u32x2*)orow + lane;
#pragma unroll
    for (int j = 0; j < 4; ++j) { u32x2 w; w.x = cvt_pk_bf16(v[j][0], v[j][1]); w.y = cvt_pk_bf16(v[j][2], v[j][3]); o8[64 * j] = w; }
    return wave_sum(s);
}

__device__ __forceinline__ void convert_items(KP pp, int l, int r0, int r1, int gw, int NGW, int lane) {
    int g = r0 + gw; TrDesc d; f32x4 v[16];
    if (g >= r1) return;
    d = tr_desc(pp, l, g); tr_load(d, lane, v);
#pragma unroll 1
    while (g < r1) {
        const int gn = g + NGW; TrDesc dn = d; f32x4 vn[16];
        if (gn < r1) { dn = tr_desc(pp, l, gn); tr_load(dn, lane, vn); }
        else {
#pragma unroll
            for (int i = 0; i < 16; ++i) vn[i] = v[i];
        }
        tr_store(d, lane, v);
#pragma unroll
        for (int i = 0; i < 16; ++i) v[i] = vn[i];
        d = dn; g = gn;
    }
}
__device__ __forceinline__ void convert_in_tail(int lnext, int kmin, int f0, int f1, int skip_last = 0) {
    if (lnext >= DEPTH) return;
    const int bid = opaque_bid(), j = bid >> 3, k = j >> 3;
    if (k < kmin || j >= 32 - skip_last) return;
    const KP pp = kparams();
    const int tid = opaque_tid(), lane = tid & 63, wave = tid >> 6;
    const int cidx = (j - 8 * kmin) * 8 + (bid & 7), ncu = (4 - kmin) * 64 - 8 * skip_last;
    convert_items(pp, lnext, TR_L_MAIN * f0 / 16, TR_L_MAIN * f1 / 16, cidx * 8 + wave, ncu * 8, lane);
}
__device__ __forceinline__ void prologue(LAS unsigned char* lds) {
    const KP pp = kparams();
    const int tid = opaque_tid(), lane = tid & 63, wave = tid >> 6;
    const int G = gridDim.x, gw = blockIdx.x * 8 + wave, NGW = G * 8;
    unsigned char* ws = pp->ws;
    convert_items(pp, 0, 0, TR_L_ITEMS, gw, NGW, lane);
#pragma unroll 1
    for (int l = 1; l < DEPTH; ++l) {
        const int shift = (TR_L_ITEMS + 128 * (l - 1)) % NGW;
        convert_items(pp, l, TR_L_MAIN, TR_L_ITEMS, (gw + NGW - shift) % NGW, NGW, lane);
    }
#pragma unroll 1
    for (int l = 0; l < DEPTH; ++l) {
        unsigned char* wl = ws + WS_W + (size_t)l * SZ_LAYER;
        u32x4* z = (u32x4*)(wl + OFF_WIN + (size_t)DIN * DM * 2); const int n16 = (DINP - DIN) * DM * 2 / 16;
        for (int i = blockIdx.x * 512 + tid; i < n16; i += G * 512) z[i] = (u32x4){0u, 0u, 0u, 0u};
    }
    {
        bf16_t* RB = (bf16_t*)(ws + WS_RB); float* PB = (float*)(ws + WS_PB);
        for (int m0 = gw * 4; m0 < M; m0 += NGW * 4) {
            f32x4 v[4][4];
#pragma unroll
            for (int r = 0; r < 4; ++r)
#pragma unroll
                for (int j = 0; j < 4; ++j) v[r][j] = __builtin_nontemporal_load((const f32x4*)(pp->x + (size_t)(m0 + r) * DM) + lane + 64 * j);
#pragma unroll
            for (int r = 0; r < 4; ++r) {
                float sq = 0.f; u32x2* o8 = (u32x2*)(RB + (size_t)(m0 + r) * DM) + lane;
#pragma unroll
                for (int j = 0; j < 4; ++j) { const f32x4 t = v[r][j]; sq += (t[0] * t[0] + t[1] * t[1]) + (t[2] * t[2] + t[3] * t[3]);
                    u32x2 w; w.x = cvt_pk_bf16(t[0], t[1]); w.y = cvt_pk_bf16(t[2], t[3]); o8[64 * j] = w; }
                sq = wave_sum(sq);
                if (lane < 16) PB[(size_t)(m0 + r) * 16 + lane] = lane == 0 ? sq : 0.f;
            }
        }
        bf16_t* MB = (bf16_t*)(ws + WS_MEMB); float* PM = (float*)(ws + WS_PM);
        for (int m = gw; m < MROWS; m += NGW) { const float s = row_to_bf16(pp->mem + (size_t)m * DM, MB + (size_t)m * DM, lane); if (lane < 16) PM[(size_t)m * 16 + lane] = lane == 0 ? s : 0.f; }
    }
}

constexpr int KS_STRIDE = 144, VT_STRIDE = 544;
constexpr int LDS_KS = 0, LDS_VT = 256 * KS_STRIDE;
constexpr float QSCALE = 0.125f * 1.4426950408889634f;

struct RowTask { bf16x8 lo, hi; int pos; };
template <bool ROPE>
__device__ __forceinline__ void row_issue(RowTask& t, const bf16_t* rowp, const int* posp, int c) {
    t.lo = *(const bf16x8*)(rowp + 8 * c); t.hi = *(const bf16x8*)(rowp + 32 + 8 * c);
    if (ROPE) t.pos = *posp;
}
__device__ __forceinline__ void rope_freqs(int c, float (&f)[8]) {
#pragma unroll
    for (int e = 0; e < 8; ++e) f[e] = __builtin_amdgcn_exp2f(-(float)(8 * c + e) * (13.287712379549449f / 32.0f)) * 0.15915494309189535f;
}
template <bool ROPE>
__device__ __forceinline__ void row_finish(const RowTask& t, bool valid, const f32x4 (&g)[4], const float (&rf)[8], float scale, int m1, int m2, u32x4& w1, u32x4& w2) {
    float x1[8], x2[8]; float ss = 0.f;
#pragma unroll
    for (int e = 0; e < 8; ++e) { x1[e] = valid ? bf2f(t.lo[e]) : 0.f; x2[e] = valid ? bf2f(t.hi[e]) : 0.f; ss += x1[e] * x1[e] + x2[e] * x2[e]; }
    ss += __shfl_xor(ss, m1); ss += __shfl_xor(ss, m2);
    const float rs = scale * __builtin_amdgcn_rsqf(ss * (1.0f / 64.0f) + EPS);
#pragma unroll
    for (int e = 0; e < 4; ++e) { x1[e] *= rs * g[0][e]; x1[4 + e] *= rs * g[1][e]; x2[e] *= rs * g[2][e]; x2[4 + e] *= rs * g[3][e]; }
    if (ROPE) {
        const float pf = (float)t.pos;
#pragma unroll
        for (int e = 0; e < 8; ++e) { const float rev = __builtin_amdgcn_fractf(pf * rf[e]); const float cc = __builtin_amdgcn_cosf(rev), sn = __builtin_amdgcn_sinf(rev);
            const float a = x1[e], b = x2[e]; x1[e] = a * cc - b * sn; x2[e] = b * cc + a * sn; }
    }
    w1.x = cvt_pk_bf16(x1[0], x1[1]); w1.y = cvt_pk_bf16(x1[2], x1[3]); w1.z = cvt_pk_bf16(x1[4], x1[5]); w1.w = cvt_pk_bf16(x1[6], x1[7]);
    w2.x = cvt_pk_bf16(x2[0], x2[1]); w2.y = cvt_pk_bf16(x2[2], x2[3]); w2.z = cvt_pk_bf16(x2[4], x2[5]); w2.w = cvt_pk_bf16(x2[6], x2[7]);
}
__device__ __forceinline__ void load_gains(const float* g, int c, f32x4 (&o)[4]) { o[0] = *(const f32x4*)(g + 8 * c); o[1] = *(const f32x4*)(g + 8 * c + 4); o[2] = *(const f32x4*)(g + 32 + 8 * c); o[3] = *(const f32x4*)(g + 36 + 8 * c); }
__device__ __forceinline__ void vt_store(LAS unsigned char* lds, bf16x8 v, bool valid, int r, int c) {
#pragma unroll
    for (int e = 0; e < 8; ++e) *(LAS short*)(lds + LDS_VT + (8 * c + e) * VT_STRIDE + 2 * r) = valid ? v[e] : (short)0;
}

template <int NT, bool SWA, int NQ>
__device__ __forceinline__ void attn_multi(LAS const unsigned char* lds, const bf16x8 (&q0)[NQ], const bf16x8 (&q1)[NQ], int kt0, int i0, bool first_blk, const float (&sink2)[NQ], bf16_t* const (&orow)[NQ], int fr, int fq) {
    f32x4 s[NQ][NT];
    {
        const LAS unsigned char* kp = lds + LDS_KS + (16 * kt0 + fr) * KS_STRIDE + 16 * fq;
        bf16x8 kc0 = *(const LAS bf16x8*)kp, kc1 = *(const LAS bf16x8*)(kp + 64);
#pragma unroll
        for (int t = 0; t < NT; ++t) {
            bf16x8 kn0 = kc0, kn1 = kc1;
            if (t + 1 < NT) { kn0 = *(const LAS bf16x8*)(kp + (t + 1) * 16 * KS_STRIDE); kn1 = *(const LAS bf16x8*)(kp + (t + 1) * 16 * KS_STRIDE + 64); }
#pragma unroll
            for (int n = 0; n < NQ; ++n) {
                f32x4 a = {0.f, 0.f, 0.f, 0.f};
                a = __builtin_amdgcn_mfma_f32_16x16x32_bf16(kc0, q0[n], a, 0, 0, 0);
                a = __builtin_amdgcn_mfma_f32_16x16x32_bf16(kc1, q1[n], a, 0, 0, 0);
                s[n][t] = a;
            }
            kc0 = kn0; kc1 = kn1;
        }
    }
    float l[NQ];
#pragma unroll
    for (int n = 0; n < NQ; ++n) {
        float mx = -INFINITY;
#pragma unroll
        for (int t = 0; t < NT; ++t)
#pragma unroll
            for (int j = 0; j < 4; ++j) {
                if (SWA) { const int kj = 16 * (kt0 + t) + 4 * fq + j, i = i0 + fr; const bool ok = (kj >= i + 1) && (kj <= i + 128) && (!first_blk || kj >= 128); if (!ok) s[n][t][j] = -INFINITY; }
                mx = fmaxf(mx, s[n][t][j]);
            }
        mx = fmaxf(mx, __shfl_xor(mx, 16)); mx = fmaxf(mx, __shfl_xor(mx, 32));
        float ls = 0.f;
#pragma unroll
        for (int t = 0; t < NT; ++t)
#pragma unroll
            for (int j = 0; j < 4; ++j) { const float pv = __builtin_amdgcn_exp2f(s[n][t][j] - mx); ls += pv; s[n][t][j] = pv; }
        ls += __shfl_xor(ls, 16); ls += __shfl_xor(ls, 32);
        if (SWA) ls += __builtin_amdgcn_exp2f(sink2[n] - mx);
        l[n] = ls;
    }
    f32x4 o[NQ][4];
#pragma unroll
    for (int n = 0; n < NQ; ++n)
#pragma unroll
        for (int dt = 0; dt < 4; ++dt) o[n][dt] = (f32x4){0.f, 0.f, 0.f, 0.f};
    constexpr int NSP = (NT + 1) / 2;
    const LAS unsigned char* vbase = lds + LDS_VT + fr * VT_STRIDE + 2 * (16 * kt0 + 4 * fq);
    u32x2 va[4][2], vn[4][2];
#pragma unroll
    for (int dt = 0; dt < 4; ++dt) { va[dt][0] = *(const LAS u32x2*)(vbase + 16 * dt * VT_STRIDE); va[dt][1] = *(const LAS u32x2*)(vbase + 16 * dt * VT_STRIDE + 32); }
#pragma unroll
    for (int sp = 0; sp < NSP; ++sp) {
        if (sp + 1 < NSP) {
#pragma unroll
            for (int dt = 0; dt < 4; ++dt) { vn[dt][0] = *(const LAS u32x2*)(vbase + 16 * dt * VT_STRIDE + 64 * (sp + 1)); vn[dt][1] = *(const LAS u32x2*)(vbase + 16 * dt * VT_STRIDE + 64 * (sp + 1) + 32); }
        }
        bf16x8 pb[NQ];
#pragma unroll
        for (int n = 0; n < NQ; ++n) {
            u32x4 pw; pw.x = cvt_pk_bf16(s[n][2 * sp][0], s[n][2 * sp][1]); pw.y = cvt_pk_bf16(s[n][2 * sp][2], s[n][2 * sp][3]);
            if (2 * sp + 1 < NT) { pw.z = cvt_pk_bf16(s[n][(2 * sp + 1) % NT][0], s[n][(2 * sp + 1) % NT][1]); pw.w = cvt_pk_bf16(s[n][(2 * sp + 1) % NT][2], s[n][(2 * sp + 1) % NT][3]); } else { pw.z = 0u; pw.w = 0u; }
            pb[n] = __builtin_bit_cast(bf16x8, pw);
        }
#pragma unroll
        for (int dt = 0; dt < 4; ++dt) {
            u32x4 vw; vw.x = va[dt][0].x; vw.y = va[dt][0].y; vw.z = va[dt][1].x; vw.w = va[dt][1].y;
            const bf16x8 vf = __builtin_bit_cast(bf16x8, vw);
#pragma unroll
            for (int n = 0; n < NQ; ++n) o[n][dt] = __builtin_amdgcn_mfma_f32_16x16x32_bf16(vf, pb[n], o[n][dt], 0, 0, 0);
        }
        if (sp + 1 < NSP) {
#pragma unroll
            for (int dt = 0; dt < 4; ++dt) { va[dt][0] = vn[dt][0]; va[dt][1] = vn[dt][1]; }
        }
    }
#pragma unroll
    for (int n = 0; n < NQ; ++n) {
        const float inv = __builtin_amdgcn_rcpf(l[n]);
#pragma unroll
        for (int dt = 0; dt < 4; ++dt) { u32x2 w; w.x = cvt_pk_bf16(o[n][dt][0] * inv, o[n][dt][1] * inv); w.y = cvt_pk_bf16(o[n][dt][2] * inv, o[n][dt][3] * inv); *(u32x2*)(orow[n] + 16 * dt + 4 * fq) = w; }
    }
}

__device__ __forceinline__ void swa_unit(LAS unsigned char* lds, int l, int unit) {
    const KP pp = kparams(); struct { unsigned char* ws; const float* swa_k_norm; const float* swa_q_norm; const float* swa_sinks; } p = {pp->ws, pp->swa_k_norm, pp->swa_q_norm, pp->swa_sinks};
    const int tid = opaque_tid(), lane = tid & 63, wave = tid >> 6, fr = lane & 15, fq = lane >> 4;
    const int kvh = unit & 1, blk = (unit >> 1) & 63, b = unit >> 7;
    const bf16_t* P = (const bf16_t*)(p.ws + WS_P); bf16_t* Y = (bf16_t*)(p.ws + WS_Y);
    const int* posv = pp->pos;
    const long row0 = (long)b * SEQ + (long)blk * 128 - 128;
    const int row_lo = blk == 0 ? 128 : 0;
    RowTask kt[2], qt[3]; bf16x8 vv[4]; f32x4 gk[4], gq[4]; float sink2[3];
    const int kc = tid & 3;
#pragma unroll
    for (int it = 0; it < 2; ++it) { const int r = (tid + it * 512) >> 2, rr = r < row_lo ? row_lo : r; const long m = row0 + rr;
        row_issue<true>(kt[it], P + m * DINP + PC_K + kvh * 64, posv + m, kc); }
#pragma unroll
    for (int it = 0; it < 4; ++it) { const int task = tid + it * 512, r = task & 255, c = task >> 8, rr = r < row_lo ? row_lo : r;
        vv[it] = *(const bf16x8*)(P + (row0 + rr) * DINP + PC_V + kvh * 64 + 8 * c); }
#pragma unroll
    for (int gi3 = 0; gi3 < 3; ++gi3) { const int gidx = wave + 8 * gi3, g = gidx >> 3, gi = gidx & 7, hq = kvh * 3 + g;
        const long tok = (long)b * SEQ + (long)blk * 128 + 16 * gi + fr;
        row_issue<true>(qt[gi3], P + tok * DINP + PC_Q + hq * 64, posv + tok, fq);
        sink2[gi3] = p.swa_sinks[l * 6 + hq] * 1.4426950408889634f; }
    load_gains(p.swa_k_norm + l * 64, kc, gk); load_gains(p.swa_q_norm + l * 64, fq, gq);
    float rfk[8], rfq[8]; rope_freqs(kc, rfk); rope_freqs(fq, rfq);
#pragma unroll
    for (int it = 0; it < 2; ++it) { const int r = (tid + it * 512) >> 2; u32x4 w1, w2;
        row_finish<true>(kt[it], r >= row_lo, gk, rfk, 1.0f, 1, 2, w1, w2);
        *(LAS u32x4*)(lds + LDS_KS + r * KS_STRIDE + 16 * kc) = w1; *(LAS u32x4*)(lds + LDS_KS + r * KS_STRIDE + 64 + 16 * kc) = w2; }
#pragma unroll
    for (int it = 0; it < 4; ++it) { const int task = tid + it * 512, r = task & 255, c = task >> 8; vt_store(lds, vv[it], r >= row_lo, r, c); }
    if (tid < 128) { const unsigned z = opaque_zero(); *(LAS u32x4*)(lds + LDS_VT + (tid >> 1) * VT_STRIDE + 512 + 16 * (tid & 1)) = (u32x4){z, z, z, z}; }
    bf16x8 q0[3], q1[3];
#pragma unroll
    for (int gi3 = 0; gi3 < 3; ++gi3) { u32x4 w1, w2; row_finish<true>(qt[gi3], true, gq, rfq, QSCALE, 16, 32, w1, w2); q0[gi3] = __builtin_bit_cast(bf16x8, w1); q1[gi3] = __builtin_bit_cast(bf16x8, w2); }
    __syncthreads();
    {
        const long tok = (long)b * SEQ + (long)blk * 128 + 16 * wave + fr;
        bf16_t* const orow[3] = {Y + tok * DM + YC_SWA + (kvh * 3 + 0) * 64, Y + tok * DM + YC_SWA + (kvh * 3 + 1) * 64, Y + tok * DM + YC_SWA + (kvh * 3 + 2) * 64};
        attn_multi<9, true, 3>(lds, q0, q1, wave, 16 * wave, blk == 0, sink2, orow, fr, fq);
    }
    __syncthreads();
}
__device__ __forceinline__ void mem_unit(LAS unsigned char* lds, int l, int unit) {
    const KP pp = kparams(); struct { unsigned char* ws; const float* mem_k_norm; const float* mem_q_norm; } p = {pp->ws, pp->mem_k_norm, pp->mem_q_norm};
    const int tid = opaque_tid(), lane = tid & 63, wave = tid >> 6, fr = lane & 15, fq = lane >> 4;
    const int h = unit & 3, blk = (unit >> 2) & 31, b = unit >> 7;
    const bf16_t* P = (const bf16_t*)(p.ws + WS_P); bf16_t* Y = (bf16_t*)(p.ws + WS_Y);
    const bf16_t* MKV = (const bf16_t*)(p.ws + WS_MKV) + (long)b * MEMLEN * 2048 + l * 512 + h * 64;
    RowTask kt[2], qt[2]; bf16x8 vv[4]; f32x4 gk[4], gq[4];
    const int kc = tid & 3;
#pragma unroll
    for (int it = 0; it < 2; ++it) { const int r = (tid + it * 512) >> 2; row_issue<false>(kt[it], MKV + (long)r * 2048, nullptr, kc); }
#pragma unroll
    for (int it = 0; it < 4; ++it) { const int task = tid + it * 512, r = task & 255, c = task >> 8; vv[it] = *(const bf16x8*)(MKV + (long)r * 2048 + 256 + 8 * c); }
#pragma unroll
    for (int g2 = 0; g2 < 2; ++g2) { const long tok = (long)b * SEQ + (long)blk * 256 + 16 * (wave + 8 * g2) + fr; row_issue<false>(qt[g2], P + tok * DINP + PC_QM + h * 64, nullptr, fq); }
    load_gains(p.mem_k_norm + l * 64, kc, gk); load_gains(p.mem_q_norm + l * 64, fq, gq);
    const float rf0[8] = {0.f, 0.f, 0.f, 0.f, 0.f, 0.f, 0.f, 0.f};
#pragma unroll
    for (int it = 0; it < 2; ++it) { const int r = (tid + it * 512) >> 2; u32x4 w1, w2;
        row_finish<false>(kt[it], true, gk, rf0, 1.0f, 1, 2, w1, w2);
        *(LAS u32x4*)(lds + LDS_KS + r * KS_STRIDE + 16 * kc) = w1; *(LAS u32x4*)(lds + LDS_KS + r * KS_STRIDE + 64 + 16 * kc) = w2; }
#pragma unroll
    for (int it = 0; it < 4; ++it) { const int task = tid + it * 512, r = task & 255, c = task >> 8; vt_store(lds, vv[it], true, r, c); }
    if (tid < 128) { const unsigned z = opaque_zero(); *(LAS u32x4*)(lds + LDS_VT + (tid >> 1) * VT_STRIDE + 512 + 16 * (tid & 1)) = (u32x4){z, z, z, z}; }
    bf16x8 q0[2], q1[2];
#pragma unroll
    for (int g2 = 0; g2 < 2; ++g2) { u32x4 w1, w2; row_finish<false>(qt[g2], true, gq, rf0, QSCALE, 16, 32, w1, w2); q0[g2] = __builtin_bit_cast(bf16x8, w1); q1[g2] = __builtin_bit_cast(bf16x8, w2); }
    __syncthreads();
    {
        const long tok = (long)b * SEQ + (long)blk * 256 + 16 * wave + fr;
        bf16_t* const orow[2] = {Y + tok * DM + YC_MEM + h * 64, Y + (tok + 128) * DM + YC_MEM + h * 64};
        const float nosink[2] = {0.f, 0.f};
        attn_multi<16, false, 2>(lds, q0, q1, 0, 0, false, nosink, orow, fr, fq);
    }
    __syncthreads();
}
typedef __bf16 v2bf16 __attribute__((ext_vector_type(2)));
constexpr int LDS_CG = 0, LDS_CW = 94 * 768, LDS_CPART = LDS_CW + 16 * CONVC * 4, LDS_CSTAT = LDS_CPART + 48 * 65 * 8;
static_assert(LDS_CSTAT + 512 <= 131072, "conv LDS map");
__device__ __forceinline__ float dot2bf(unsigned a, unsigned b, float c) { return __builtin_amdgcn_fdot2_f32_bf16(__builtin_bit_cast(v2bf16, a), __builtin_bit_cast(v2bf16, b), c, false); }
__device__ __forceinline__ void conv_unit(LAS unsigned char* lds, int l, int unit) {
    const KP pp = kparams(); struct { unsigned char* ws; const float* conv_w; const float* conv_b; const float* conv_ln_g; const float* conv_ln_b; } p = {pp->ws, pp->conv_w, pp->conv_b, pp->conv_ln_g, pp->conv_ln_b};
    const int tid = opaque_tid();
    const int tb = unit & 127, b = unit >> 7, t0 = tb * 64;
    const bf16_t* P = (const bf16_t*)(p.ws + WS_P); bf16_t* Y = (bf16_t*)(p.ws + WS_Y);
    const float* cw = p.conv_w + (size_t)l * CONVW * CONVC; const float* cb = p.conv_b + l * CONVC;
    const float* lg = p.conv_ln_g + l * CONVC; const float* lb = p.conv_ln_b + l * CONVC;
    {
        bf16x8 av[9], gv[9]; float w0[12], w1[12];
#pragma unroll
        for (int it = 0; it < 12; ++it) { const int idx = tid + it * 512, jp = idx / CONVC, c = idx - jp * CONVC;
            w0[it] = cw[(2 * jp) * CONVC + c]; w1[it] = (2 * jp + 1 < CONVW) ? cw[(2 * jp + 1) * CONVC + c] : 0.f; }
        const unsigned z = opaque_zero(); const bf16x8 zv = __builtin_bit_cast(bf16x8, (u32x4){z, z, z, z});
#pragma unroll
        for (int it = 0; it < 9; ++it) {
            const int task = tid + it * 512, row = task / 48, ch = task - row * 48, t = t0 - 30 + row;
            av[it] = zv; gv[it] = zv;
            if (task < 94 * 48 && t >= 0) { const bf16_t* pr = P + ((long)b * SEQ + t) * DINP + 8 * ch; av[it] = *(const bf16x8*)(pr + PC_A); gv[it] = *(const bf16x8*)(pr + PC_G); }
        }
#pragma unroll
        for (int it = 0; it < 12; ++it) *(LAS unsigned*)(lds + LDS_CW + 4 * (tid + it * 512)) = cvt_pk_bf16(w0[it], w1[it]);
#pragma unroll
        for (int it = 0; it < 9; ++it) {
            const int task = tid + it * 512, row = task / 48, ch = task - row * 48;
            float y[8];
#pragma unroll
            for (int e = 0; e < 8; ++e) y[e] = bf2f(av[it][e]) * sigmoid_f(bf2f(gv[it][e]));
            u32x4 o; o.x = cvt_pk_bf16(y[0], y[1]); o.y = cvt_pk_bf16(y[2], y[3]); o.z = cvt_pk_bf16(y[4], y[5]); o.w = cvt_pk_bf16(y[6], y[7]);
            if (task < 94 * 48) *(LAS u32x4*)(lds + LDS_CG + row * 768 + 16 * ch) = o;
        }
    }
    __syncthreads();
    const int oct = tid % 48, grp = tid / 48;
    float acc[8][8];
    if (tid < 384) {
        const f32x4 b0 = *(const f32x4*)(cb + 8 * oct), b1 = *(const f32x4*)(cb + 8 * oct + 4);
#pragma unroll
        for (int tt = 0; tt < 8; ++tt)
#pragma unroll
            for (int e = 0; e < 4; ++e) { acc[tt][e] = b0[e]; acc[tt][4 + e] = b1[e]; }
#pragma unroll 1
        for (int jp = 0; jp < 16; ++jp) {
            const u32x4 wa = *(const LAS u32x4*)(lds + LDS_CW + (jp * CONVC + 8 * oct) * 4), wb = *(const LAS u32x4*)(lds + LDS_CW + (jp * CONVC + 8 * oct) * 4 + 16);
            u32x4 gr[9];
#pragma unroll
            for (int i = 0; i < 9; ++i) gr[i] = *(const LAS u32x4*)(lds + LDS_CG + (grp * 8 + 2 * jp + i) * 768 + 16 * oct);
#pragma unroll
            for (int tt = 0; tt < 8; ++tt) {
#pragma unroll
                for (int k = 0; k < 4; ++k) {
                    const unsigned lo = __builtin_amdgcn_perm(gr[tt + 1][k], gr[tt][k], 0x05040100u), hi = __builtin_amdgcn_perm(gr[tt + 1][k], gr[tt][k], 0x07060302u);
                    const unsigned wl = k < 2 ? wa[2 * k] : wb[2 * k - 4], wh = k < 2 ? wa[2 * k + 1] : wb[2 * k - 3];
                    acc[tt][2 * k] = dot2bf(lo, wl, acc[tt][2 * k]); acc[tt][2 * k + 1] = dot2bf(hi, wh, acc[tt][2 * k + 1]);
                }
            }
        }
#pragma unroll
        for (int tt = 0; tt < 8; ++tt) {
            float s = 0.f, q = 0.f;
#pragma unroll
            for (int e = 0; e < 8; ++e) { s += acc[tt][e]; q += acc[tt][e] * acc[tt][e]; }
            *(LAS f32x2*)(lds + LDS_CPART + (oct * 65 + grp * 8 + tt) * 8) = (f32x2){s, q};
        }
    }
    __syncthreads();
    if (tid < 64) {
        float s = 0.f, q = 0.f;
#pragma unroll 8
        for (int i = 0; i < 48; ++i) { const f32x2 v = *(LAS f32x2*)(lds + LDS_CPART + (i * 65 + tid) * 8); s += v.x; q += v.y; }
        const float mean = s * (1.0f / CONVC), var = fmaxf(q * (1.0f / CONVC) - mean * mean, 0.f);
        *(LAS float*)(lds + LDS_CSTAT + tid * 8) = mean; *(LAS float*)(lds + LDS_CSTAT + tid * 8 + 4) = 1.0f / sqrtf(var + EPS);
    }
    __syncthreads();
    if (tid < 384) {
        const f32x4 g0 = *(const f32x4*)(lg + 8 * oct), g1 = *(const f32x4*)(lg + 8 * oct + 4), b0 = *(const f32x4*)(lb + 8 * oct), b1 = *(const f32x4*)(lb + 8 * oct + 4);
#pragma unroll
        for (int tt = 0; tt < 8; ++tt) {
            const float mean = *(LAS float*)(lds + LDS_CSTAT + (grp * 8 + tt) * 8), rstd = *(LAS float*)(lds + LDS_CSTAT + (grp * 8 + tt) * 8 + 4);
            float y[8];
#pragma unroll
            for (int e = 0; e < 4; ++e) { y[e] = silu_f((acc[tt][e] - mean) * rstd * g0[e] + b0[e]); y[4 + e] = silu_f((acc[tt][4 + e] - mean) * rstd * g1[e] + b1[e]); }
            u32x4 w; w.x = cvt_pk_bf16(y[0], y[1]); w.y = cvt_pk_bf16(y[2], y[3]); w.z = cvt_pk_bf16(y[4], y[5]); w.w = cvt_pk_bf16(y[6], y[7]);
            *(u32x4*)(Y + ((long)b * SEQ + t0 + grp * 8 + tt) * DM + YC_CONV + 8 * oct) = w;
        }
    }
    __syncthreads();
}

__device__ __forceinline__ void phase_up(LAS unsigned char* lds, int l, int half) {
    const KP p = kparams(); unsigned char* ws = p->ws; const int G = gridDim.x, bid = opaque_bid();
    unsigned char* wl = ws + WS_W + (size_t)l * SZ_LAYER;
    pg8::Gemm g{(const bf16_t*)(ws + WS_RB), (const bf16_t*)(wl + (half ? OFF_W13B : OFF_W13A)), M, 2 * DFF, DM};
    pg8::PanelOrder S; S.init(2 * DFF, bid);
    pg8::EpiSwiglu E{(bf16_t*)(ws + WS_FF), pg8::RowScaleSpec{(const float*)(ws + WS_PA), (const float*)(ws + (half ? WS_PC : WS_PB)), (half == 0 && l > 0) ? 1 : 0, 1}};
    pg8::gemm_phase<pg8::EpiSwiglu, pg8::PanelOrder, true>(lds, g, S, E);
}
__device__ __forceinline__ void phase_memkv(LAS unsigned char* lds) {
    const KP p = kparams(); unsigned char* ws = p->ws; const int G = gridDim.x, bid = opaque_bid();
    if (bid < G - 16) return;
    pg8::Gemm gm{(const bf16_t*)(ws + WS_MEMB), (const bf16_t*)(ws + WS_WM), MROWS, 2048, DM};
    pg8::StaticOrder Sm; Sm.init(MROWS, 2048, 16, bid - (G - 16));
    pg8::EpiProj Em{(bf16_t*)(ws + WS_MKV), 2048, pg8::RowScaleSpec{(const float*)(ws + WS_PM), nullptr, 1, 0}};
    pg8::gemm_phase<pg8::EpiProj, pg8::StaticOrder, true>(lds, gm, Sm, Em);
}
__device__ __forceinline__ void phase_resid(LAS unsigned char* lds, int l, int kind) {
    const KP p = kparams(); unsigned char* ws = p->ws; const int G = gridDim.x, bid = opaque_bid();
    unsigned char* wl = ws + WS_W + (size_t)l * SZ_LAYER;
    bf16_t* RB = (bf16_t*)(ws + WS_RB);
    float* PA = (float*)(ws + WS_PA); float* PB = (float*)(ws + WS_PB); float* PC = (float*)(ws + WS_PC);
    pg8::Gemm g; pg8::EpiResid E;
    if (kind == 0) { g = pg8::Gemm{(const bf16_t*)(ws + WS_FF), (const bf16_t*)(wl + OFF_W2A), M, DM, DFF}; E = pg8::EpiResid{RB, pg8::RowScaleSpec{PA, nullptr, l == 0 ? 0 : 1, 0}, 0.5f, nullptr, PC, nullptr}; }
    else if (kind == 1) { g = pg8::Gemm{(const bf16_t*)(ws + WS_FF), (const bf16_t*)(wl + OFF_W2B), M, DM, DFF}; E = pg8::EpiResid{RB, pg8::RowScaleSpec{PA, nullptr, 0, 0}, 0.5f, p->final_norm + l * DM, PA, PB}; }
    else { g = pg8::Gemm{(const bf16_t*)(ws + WS_Y), (const bf16_t*)(wl + OFF_WOUT), M, DM, DM}; E = pg8::EpiResid{RB, pg8::RowScaleSpec{PA, nullptr, 0, 0}, 1.0f, nullptr, PC, nullptr}; }
    pg8::PanelOrder S; S.init(DM, bid);
    pg8::gemm_phase<pg8::EpiResid, pg8::PanelOrder, true>(lds, g, S, E);
}
__device__ __forceinline__ void phase_resid_final(LAS unsigned char* lds, int l) {
    const KP p = kparams(); unsigned char* ws = p->ws; const int bid = opaque_bid();
    unsigned char* wl = ws + WS_W + (size_t)l * SZ_LAYER;
    pg8::Gemm g{(const bf16_t*)(ws + WS_FF), (const bf16_t*)(wl + OFF_W2B), M, DM, DFF};
    pg8::EpiFinal E{(const bf16_t*)(ws + WS_RB), pg8::RowScaleSpec{nullptr, nullptr, 0, 0}, 0.5f, p->final_norm + l * DM, p->out, (float*)(ws + WS_XBUF), (unsigned*)(ws + WS_CTL) + CW_PANEL};
    pg8::PanelOrder S; S.init(DM, bid);
    pg8::gemm_phase<pg8::EpiFinal, pg8::PanelOrder, true>(lds, g, S, E);
}
__device__ __forceinline__ void phase_win(LAS unsigned char* lds, int l) {
    const KP p = kparams(); unsigned char* ws = p->ws; const int G = gridDim.x, bid = opaque_bid();
    unsigned char* wl = ws + WS_W + (size_t)l * SZ_LAYER;
    pg8::Gemm g{(const bf16_t*)(ws + WS_RB), (const bf16_t*)(wl + OFF_WIN), M, DINP, DM};
    pg8::PanelOrder S; S.init(DINP, bid);
    pg8::EpiProj E{(bf16_t*)(ws + WS_P), DINP, pg8::RowScaleSpec{(const float*)(ws + WS_PC), nullptr, 1, 0}};
    pg8::gemm_phase<pg8::EpiProj, pg8::PanelOrder, true>(lds, g, S, E);
}
__device__ __forceinline__ void phase_final() {
    const KP p = kparams(); unsigned char* ws = p->ws; const int G = gridDim.x, bid = opaque_bid();
    const float* PA = (const float*)(ws + WS_PA); float* R = p->out; const bf16_t* RB = (const bf16_t*)(ws + WS_RB);
    const int tid = opaque_tid(), lane = tid & 63, wave = tid >> 6, gw = bid * 8 + wave, NGW = G * 8;
    for (int m = gw; m < M; m += NGW) {
        float s = lane < 16 ? PA[(size_t)m * 16 + lane] : 0.f; s = wave_sum(s);
        const float r3 = 1.0f / sqrtf(s * (1.0f / DM) + EPS);
#pragma unroll
        for (int j = 0; j < 2; ++j) {
            const bf16x8 v = *(const bf16x8*)(RB + (size_t)m * DM + 512 * j + 8 * lane);
            f32x4* o = (f32x4*)(R + (size_t)m * DM + 512 * j + 8 * lane);
            o[0] = (f32x4){bf2f(v[0]) * r3, bf2f(v[1]) * r3, bf2f(v[2]) * r3, bf2f(v[3]) * r3};
            o[1] = (f32x4){bf2f(v[4]) * r3, bf2f(v[5]) * r3, bf2f(v[6]) * r3, bf2f(v[7]) * r3};
        }
    }
}

__global__ void __launch_bounds__(512, 2) fwd_megakernel(Params p_unused) {
    extern __shared__ __attribute__((aligned(16))) unsigned char lds_raw[];
    LAS unsigned char* lds = (LAS unsigned char*)lds_raw;
    cg::grid_group grid = cg::this_grid();
    if (threadIdx.x < 2) ((LAS unsigned*)(lds + LDS_MISC))[threadIdx.x] = 0u;
    if (threadIdx.x == 0) (void)xb_add((unsigned*)(kparams()->ws + WS_CTL) + XB_XCNT(xb_xcc_id()), 1u);
    __syncthreads();

    prologue(lds);
    if (gridDim.x == 0x7fffffffu) grid.sync();
    xcd_barrier(lds);
#pragma unroll 1
    for (int l = 0; l < DEPTH; ++l) {
        phase_up(lds, l, 0);
        if (l == 0) phase_memkv(lds);
        convert_in_tail(l + 1, 2, 0, 6, l == 0 ? 2 : 0);
        xcd_barrier(lds);
        phase_resid(lds, l, 0);
        xcd_barrier(lds);
        phase_win(lds, l);
        convert_in_tail(l + 1, 3, 6, 9);
        xcd_barrier(lds);
#pragma unroll 1
        for (int it = blockIdx.x; it < 768; it += gridDim.x) {
            if (it < 256) swa_unit(lds, l, it);
            else if (it < 512) conv_unit(lds, l, it - 256);
            else mem_unit(lds, l, it - 512);
        }
        xcd_barrier(lds);
        phase_resid(lds, l, 2);
        xcd_barrier(lds);
        phase_up(lds, l, 1);
        convert_in_tail(l + 1, 2, 9, 16);
        xcd_barrier(lds);
        if (l < DEPTH - 1) { phase_resid(lds, l, 1); xcd_barrier(lds); }
        else phase_resid_final(lds, l);
    }
}

extern "C" void kernel_launch(void* const* d_in, const int* in_sizes, int n_in, void* d_out, int out_size, void* d_ws, size_t ws_size, hipStream_t stream) {
    static int grid = 0;
    if (grid == 0) {
        if (n_in != 26 || in_sizes[0] != M * DM || out_size != M * DM || ws_size < WS_END) { fprintf(stderr, "kernel_launch: unexpected shapes (n_in %d in0 %d out %d ws %zu)\n", n_in, n_in > 0 ? in_sizes[0] : -1, out_size, ws_size); grid = -1; return; }
        int dev = 0, cus = 0, per_cu = 0;
        hipGetDevice(&dev);
        hipDeviceGetAttribute(&cus, hipDeviceAttributeMultiprocessorCount, dev);
        hipFuncSetAttribute((const void*)fwd_megakernel, hipFuncAttributeMaxDynamicSharedMemorySize, LDS_BYTES);
        hipOccupancyMaxActiveBlocksPerMultiprocessor(&per_cu, (const void*)fwd_megakernel, 512, LDS_BYTES);
        (void)hipGetLastError();
        if (per_cu < 1) fprintf(stderr, "kernel_launch: occupancy query says %d blocks per CU\n", per_cu);
        grid = cus;
        if (grid != 256) { fprintf(stderr, "kernel_launch: this kernel's tile assignment is built for 256 CUs, found %d; launching 256 workgroups anyway\n", cus); grid = 256; }
    }
    if (grid < 0) return;
    Params p{};
    p.x = (const float*)d_in[0]; p.mem = (const float*)d_in[1]; p.pos = (const int*)d_in[2];
    p.ffn1_norm = (const float*)d_in[3]; p.ffn1_w1 = (const float*)d_in[4]; p.ffn1_w3 = (const float*)d_in[5]; p.ffn1_w2 = (const float*)d_in[6];
    p.mix_norm = (const float*)d_in[7]; p.w_in = (const float*)d_in[8]; p.conv_w = (const float*)d_in[9]; p.conv_b = (const float*)d_in[10];
    p.conv_ln_g = (const float*)d_in[11]; p.conv_ln_b = (const float*)d_in[12]; p.swa_q_norm = (const float*)d_in[13]; p.swa_k_norm = (const float*)d_in[14];
    p.swa_sinks = (const float*)d_in[15]; p.mem_norm = (const float*)d_in[16]; p.w_mem_kv = (const float*)d_in[17]; p.mem_q_norm = (const float*)d_in[18];
    p.mem_k_norm = (const float*)d_in[19]; p.w_out = (const float*)d_in[20]; p.ffn2_norm = (const float*)d_in[21]; p.ffn2_w1 = (const float*)d_in[22];
    p.ffn2_w3 = (const float*)d_in[23]; p.ffn2_w2 = (const float*)d_in[24]; p.final_norm = (const float*)d_in[25];
    p.out = (float*)d_out; p.ws = (unsigned char*)d_ws;
    if (hipMemsetAsync((char*)d_ws + WS_CTL, 0, CTL_ZERO_BYTES, stream) != hipSuccess) { fprintf(stderr, "kernel_launch: memset failed\n"); return; }
    void* args[] = {&p};
    hipError_t e = hipLaunchCooperativeKernel((const void*)fwd_megakernel, dim3(grid), dim3(512), args, LDS_BYTES, stream);
    if (e != hipSuccess) fprintf(stderr, "kernel_launch: cooperative launch failed: %s (grid %d)\n", hipGetErrorString(e), grid);
}
```
